# Optimizing an MI355X kernel written in HIP

```python
import math
import jax, jax.numpy as jnp
from jax import lax
import numpy as np

D_MODEL = 2048
BATCH = 1
SEQ = 8192
DEPTH = 1
DEC_BATCH = 32
DEC_SEQ = 32
PAST_LEN = 4096

CHUNK = 64
MIX_W = D_MODEL
RET_HEADS = 4
RET_DK = 256
RET_DV = 256
RET_W = RET_HEADS * RET_DV
MLA_HEADS = 8
Q_LORA = 512
KV_LORA = 512
NOPE_DIM = 128
ROPE_DIM = 64
V_HEAD = 128
QK_HEAD = NOPE_DIM + ROPE_DIM
MLA_W = MLA_HEADS * V_HEAD
ROPE_BASE = 10000.0
Q_BLOCK = 128
NEG_INF = -1e30
N_KEYS = 128
N_EXPERTS = N_KEYS * N_KEYS
PEER_HEADS = 8
PEER_QDIM = 256
PEER_HALF = PEER_QDIM // 2
PEER_TOPK = 16
PEER_BLOCK = 128
PLE_DIM = 256
EPS = 1e-6
OFF_RQ = 0
OFF_RK = OFF_RQ + RET_HEADS * RET_DK
OFF_RV = OFF_RK + RET_HEADS * RET_DK
OFF_RG = OFF_RV + RET_W
OFF_CQ = OFF_RG + RET_W
OFF_CKV = OFF_CQ + Q_LORA
OFF_KR = OFF_CKV + KV_LORA
IN_W = OFF_KR + ROPE_DIM

kernel_name = 'hymba_retnet_mla_peer_stream_step'


def rmsnorm(x, g):
    xf = x.astype(jnp.float32)
    y = xf * lax.rsqrt(jnp.mean(xf * xf, axis=-1, keepdims=True) + EPS)
    return (y * g.astype(jnp.float32)).astype(x.dtype)


def rope(x, pos):
    d = x.shape[-1]
    inv = ROPE_BASE ** (-jnp.arange(0, d, 2, dtype=jnp.float32) / d)
    ang = pos.astype(jnp.float32)[:, None] * inv[None, :]
    cos = jnp.cos(ang)[:, None, :]
    sin = jnp.sin(ang)[:, None, :]
    xf = x.astype(jnp.float32)
    x1, x2 = xf[..., : d // 2], xf[..., d // 2:]
    return jnp.concatenate([x1 * cos - x2 * sin, x2 * cos + x1 * sin], axis=-1).astype(x.dtype)


def retention_log_decay():
    return jnp.log1p(-jnp.exp(jnp.linspace(math.log(1.0 / 32), math.log(1.0 / 512), RET_HEADS, dtype=jnp.float32)))


def retention_chunk(q, k, v, s_prev, log_g):
    L = q.shape[1]
    idx = jnp.arange(L)
    diff = idx[:, None] - idx[None, :]
    dmask = jnp.where(diff[None] >= 0,
                      jnp.exp(jnp.maximum(diff, 0).astype(jnp.float32)[None] * log_g[:, None, None]), 0.0)
    scores = jnp.einsum('blhd,bmhd->bhlm', q, k) * dmask[None]
    intra = jnp.einsum('bhlm,bmhe->blhe', scores, v)
    inner = jnp.exp((idx + 1).astype(jnp.float32)[:, None] * log_g[None, :])
    cross = jnp.einsum('blhd,bhde->blhe', q, s_prev) * inner[None, :, :, None]
    kdec = jnp.exp((L - 1 - idx).astype(jnp.float32)[:, None] * log_g[None, :])
    s_new = jnp.exp(L * log_g)[None, :, None, None] * s_prev + \
        jnp.einsum('blhd,blhe->bhde', k * kdec[None, :, :, None], v)
    return intra + cross, s_new


def retention(q, k, v, s0):
    B, T, H, _ = q.shape
    L = min(T, CHUNK)
    nc = T // L
    log_g = retention_log_decay()

    def to_chunks(t):
        return t.reshape(B, nc, L, H, t.shape[-1]).transpose(1, 0, 2, 3, 4)

    def step(s, qkv):
        qc, kc, vc = qkv
        o, s = retention_chunk(qc, kc, vc, s, log_g)
        return s, o

    s_fin, o = lax.scan(step, s0, (to_chunks(q), to_chunks(k), to_chunks(v)))
    o = o.transpose(1, 0, 2, 3, 4).reshape(B, T, H, v.shape[-1])
    return o, s_fin


def head_groupnorm(o, g):
    mu = jnp.mean(o, axis=-1, keepdims=True)
    var = jnp.mean(jnp.square(o - mu), axis=-1, keepdims=True)
    y = (o - mu) * lax.rsqrt(var + EPS)
    B, T = o.shape[:2]
    return y.reshape(B, T, -1) * g.astype(jnp.float32)


def mla_prompt_attention(q_nope, q_rope, c_kv, k_rope, w_uk, w_uv):
    B, S, H, _ = q_nope.shape
    k_nope = jnp.einsum('bsc,chd->bshd', c_kv, w_uk)
    v = jnp.einsum('bsc,chd->bshd', c_kv, w_uv)
    nb = S // Q_BLOCK
    k_chunk = jnp.arange(S) // CHUNK
    scale = QK_HEAD ** -0.5

    def blk(args):
        qn, qr, start = args
        s = (jnp.einsum('bqhd,bkhd->bhqk', qn, k_nope) +
             jnp.einsum('bqhr,bkr->bhqk', qr, k_rope)).astype(jnp.float32) * scale
        q_chunk = (start + jnp.arange(Q_BLOCK)) // CHUNK
        mask = k_chunk[None, :] <= q_chunk[:, None]
        p = jax.nn.softmax(jnp.where(mask[None, None], s, NEG_INF), axis=-1)
        return jnp.einsum('bhqk,bkhd->bqhd', p.astype(v.dtype), v)

    qn_b = q_nope.reshape(B, nb, Q_BLOCK, H, NOPE_DIM).transpose(1, 0, 2, 3, 4)
    qr_b = q_rope.reshape(B, nb, Q_BLOCK, H, ROPE_DIM).transpose(1, 0, 2, 3, 4)
    starts = jnp.arange(nb, dtype=jnp.int32) * Q_BLOCK
    o = lax.map(blk, (qn_b, qr_b, starts))
    return o.transpose(1, 0, 2, 3, 4).reshape(B, S, H, V_HEAD)


def mla_sample_attention(q_nope, q_rope, c_new, kr_new, c_cache, kr_cache, w_uk, w_uv):
    scale = QK_HEAD ** -0.5
    P = c_cache.shape[1]
    q_lat = jnp.einsum('bthd,chd->bthc', q_nope, w_uk)
    s_past = jnp.einsum('bthc,bpc->bhtp', q_lat, c_cache) + jnp.einsum('bthr,bpr->bhtp', q_rope, kr_cache)
    s_new = jnp.einsum('bthc,bnc->bhtn', q_lat, c_new) + jnp.einsum('bthr,bnr->bhtn', q_rope, kr_new)
    s = jnp.concatenate([s_past, s_new], axis=-1).astype(jnp.float32) * scale
    p = jax.nn.softmax(s, axis=-1)
    ctx = jnp.einsum('bhtp,bpc->bthc', p[..., :P], c_cache.astype(jnp.float32)) + \
        jnp.einsum('bhtn,bnc->bthc', p[..., P:], c_new.astype(jnp.float32))
    return jnp.einsum('bthc,chd->bthd', ctx.astype(q_nope.dtype), w_uv)


def peer(m, w_pq, sub_keys, u_tab, v_tab):
    N, D = m.shape
    q = (m @ w_pq).reshape(N, PEER_HEADS, 2, PEER_HALF).astype(jnp.float32)
    sk = sub_keys.astype(jnp.float32)
    s1 = jnp.einsum('nhd,hkd->nhk', q[:, :, 0], sk[:, 0])
    s2 = jnp.einsum('nhd,hkd->nhk', q[:, :, 1], sk[:, 1])
    v1, i1 = lax.top_k(s1, PEER_TOPK)
    v2, i2 = lax.top_k(s2, PEER_TOPK)
    cand = (v1[..., :, None] + v2[..., None, :]).reshape(N, PEER_HEADS, PEER_TOPK * PEER_TOPK)
    cand_idx = (i1[..., :, None] * N_KEYS + i2[..., None, :]).reshape(N, PEER_HEADS, PEER_TOPK * PEER_TOPK)
    top_s, sel = lax.top_k(cand, PEER_TOPK)
    idx = jnp.take_along_axis(cand_idx, sel, axis=-1)
    g = jax.nn.softmax(top_s, axis=-1)
    pad = (-N) % PEER_BLOCK
    nb = (N + pad) // PEER_BLOCK
    m_p = jnp.pad(m, ((0, pad), (0, 0))).reshape(nb, PEER_BLOCK, D)
    idx_p = jnp.pad(idx, ((0, pad), (0, 0), (0, 0))).reshape(nb, PEER_BLOCK, PEER_HEADS, PEER_TOPK)
    g_p = jnp.pad(g, ((0, pad), (0, 0), (0, 0))).reshape(nb, PEER_BLOCK, PEER_HEADS, PEER_TOPK)

    def blk(args):
        mb, ib, gb = args
        u = u_tab[ib]
        h = jnp.einsum('nd,nhkd->nhk', mb, u).astype(jnp.float32)
        a = (gb * jax.nn.gelu(h, approximate=False)).astype(mb.dtype)
        return jnp.einsum('nhk,nhkd->nd', a, v_tab[ib])

    out = lax.map(blk, (m_p, idx_p, g_p))
    return out.reshape(nb * PEER_BLOCK, D)[:N]


def layer(h, p_l, pos, s0, mla_cache, w):
    (g_mix, w_in, g_q, w_uq, g_kv, w_uk, w_uv, g_ret_out, g_mla_out, w_out,
     g_ffn, w_pq, sub_keys, u_tab, v_tab, g_ple, w_ple_gate, w_ple_proj) = w
    B, T, D = h.shape
    a = rmsnorm(h, g_mix)
    z = a @ w_in
    rq = rope(z[..., OFF_RQ:OFF_RK].reshape(B, T, RET_HEADS, RET_DK), pos).astype(jnp.float32)
    rk = rope(z[..., OFF_RK:OFF_RV].reshape(B, T, RET_HEADS, RET_DK), pos).astype(jnp.float32) * (RET_DK ** -0.5)
    rv = z[..., OFF_RV:OFF_RG].reshape(B, T, RET_HEADS, RET_DV).astype(jnp.float32)
    rg = z[..., OFF_RG:OFF_CQ].astype(jnp.float32)
    o_ret, s_new = retention(rq, rk, rv, s0.astype(jnp.float32))
    o_ret = (jax.nn.silu(rg) * head_groupnorm(o_ret, g_ret_out)).astype(h.dtype)
    c_q = rmsnorm(z[..., OFF_CQ:OFF_CKV], g_q)
    qh = jnp.einsum('btc,chd->bthd', c_q, w_uq)
    q_nope = qh[..., :NOPE_DIM]
    q_rope = rope(qh[..., NOPE_DIM:], pos)
    c_kv = rmsnorm(z[..., OFF_CKV:OFF_KR], g_kv)
    k_rope = rope(z[..., OFF_KR:IN_W][:, :, None, :], pos)[:, :, 0, :]
    if mla_cache is None:
        o_mla = mla_prompt_attention(q_nope, q_rope, c_kv, k_rope, w_uk, w_uv)
    else:
        o_mla = mla_sample_attention(q_nope, q_rope, c_kv, k_rope, mla_cache[0], mla_cache[1], w_uk, w_uv)
    o_mla = rmsnorm(o_mla.reshape(B, T, MLA_W).astype(h.dtype), g_mla_out)
    h = h + jnp.concatenate([o_ret, o_mla], axis=-1) @ w_out
    h = h + peer(rmsnorm(h, g_ffn).reshape(B * T, D), w_pq, sub_keys, u_tab, v_tab).reshape(B, T, D)
    gate = jax.nn.sigmoid((rmsnorm(h, g_ple) @ w_ple_gate).astype(jnp.float32))
    h = h + (gate * (p_l @ w_ple_proj).astype(jnp.float32)).astype(h.dtype)
    return h, c_kv, k_rope, s_new.astype(h.dtype)


def setup_inputs(seed: int = 0) -> dict:
    key = jax.random.key(seed)
    ks = jax.random.split(key, 32)
    f32 = jnp.float32

    def nrm(k, shape, scale):
        return jax.random.normal(k, shape, f32) * scale

    def gain(k, shape):
        return 1.0 + 0.01 * jax.random.normal(k, shape, f32)

    return {
        'x_prompt': nrm(ks[0], (BATCH, SEQ, D_MODEL), 1.0),
        'x_sample': nrm(ks[1], (DEC_BATCH, DEC_SEQ, D_MODEL), 1.0),
        'cache_ckv': nrm(ks[2], (DEPTH, DEC_BATCH, PAST_LEN, KV_LORA), 1.0),
        'cache_krope': nrm(ks[3], (DEPTH, DEC_BATCH, PAST_LEN, ROPE_DIM), 1.0),
        'state_ret': nrm(ks[4], (DEPTH, DEC_BATCH, RET_HEADS, RET_DK, RET_DV), 0.1),
        'p_prompt': nrm(ks[5], (DEPTH, BATCH, SEQ, PLE_DIM), 1.0),
        'p_sample': nrm(ks[6], (DEPTH, DEC_BATCH, DEC_SEQ, PLE_DIM), 1.0),
        'g_mix': gain(ks[7], (DEPTH, D_MODEL)),
        'w_in': nrm(ks[8], (DEPTH, D_MODEL, IN_W), D_MODEL ** -0.5),
        'g_q': gain(ks[9], (DEPTH, Q_LORA)),
        'w_uq': nrm(ks[10], (DEPTH, Q_LORA, MLA_HEADS, QK_HEAD), Q_LORA ** -0.5),
        'g_kv': gain(ks[11], (DEPTH, KV_LORA)),
        'w_uk': nrm(ks[12], (DEPTH, KV_LORA, MLA_HEADS, NOPE_DIM), KV_LORA ** -0.5),
        'w_uv': nrm(ks[13], (DEPTH, KV_LORA, MLA_HEADS, V_HEAD), KV_LORA ** -0.5),
        'g_ret_out': gain(ks[14], (DEPTH, RET_W)),
        'g_mla_out': gain(ks[15], (DEPTH, MLA_W)),
        'w_out': nrm(ks[16], (DEPTH, MIX_W, D_MODEL), MIX_W ** -0.5),
        'g_ffn': gain(ks[17], (DEPTH, D_MODEL)),
        'w_pq': nrm(ks[18], (DEPTH, D_MODEL, PEER_HEADS * PEER_QDIM), D_MODEL ** -0.5),
        'sub_keys': nrm(ks[19], (DEPTH, PEER_HEADS, 2, N_KEYS, PEER_HALF), PEER_HALF ** -0.5),
        'u_tab': nrm(ks[20], (DEPTH, N_EXPERTS, D_MODEL), D_MODEL ** -0.5),
        'v_tab': nrm(ks[21], (DEPTH, N_EXPERTS, D_MODEL), 0.05),
        'g_ple': gain(ks[22], (DEPTH, D_MODEL)),
        'w_ple_gate': nrm(ks[23], (DEPTH, D_MODEL, D_MODEL), D_MODEL ** -0.5),
        'w_ple_proj': nrm(ks[24], (DEPTH, PLE_DIM, D_MODEL), PLE_DIM ** -0.5),
        'g_final': gain(ks[25], (D_MODEL,)),
    }


def reference(x_prompt, x_sample, cache_ckv, cache_krope, state_ret, p_prompt, p_sample,
              g_mix, w_in, g_q, w_uq, g_kv, w_uk, w_uv, g_ret_out, g_mla_out, w_out,
              g_ffn, w_pq, sub_keys, u_tab, v_tab, g_ple, w_ple_gate, w_ple_proj, g_final):
    Bp, Sp, _ = x_prompt.shape
    Bs, Ts, _ = x_sample.shape
    P = cache_ckv.shape[2]
    pos_p = jnp.arange(Sp, dtype=jnp.int32)
    pos_s = P + jnp.arange(Ts, dtype=jnp.int32)
    hp, hs = x_prompt, x_sample
    ckv_p, kr_p, ret_p, ckv_s, kr_s, ret_s = [], [], [], [], [], []
    for i in range(DEPTH):
        w = (g_mix[i], w_in[i], g_q[i], w_uq[i], g_kv[i], w_uk[i], w_uv[i], g_ret_out[i],
             g_mla_out[i], w_out[i], g_ffn[i], w_pq[i], sub_keys[i], u_tab[i], v_tab[i],
             g_ple[i], w_ple_gate[i], w_ple_proj[i])
        s0 = jnp.zeros((Bp, RET_HEADS, RET_DK, RET_DV), jnp.float32)
        hp, c1, k1, r1 = layer(hp, p_prompt[i], pos_p, s0, None, w)
        hs, c2, k2, r2 = layer(hs, p_sample[i], pos_s, state_ret[i], (cache_ckv[i], cache_krope[i]), w)
        ckv_p.append(c1); kr_p.append(k1); ret_p.append(r1)
        ckv_s.append(c2); kr_s.append(k2); ret_s.append(r2)
    y_prompt = rmsnorm(hp, g_final)
    y_sample = rmsnorm(hs, g_final)
    return (y_prompt, y_sample, jnp.stack(ckv_p), jnp.stack(kr_p), jnp.stack(ret_p),
            jnp.stack(ckv_s), jnp.stack(kr_s), jnp.stack(ret_s))
```

```cpp
#include <hip/hip_runtime.h>
#include <hip/hip_cooperative_groups.h>
#include <cstdio>
#include <cstdint>
namespace cg = cooperative_groups;

constexpr int DM = 2048, SEQ = 8192, DECB = 32, DECS = 32, PAST = 4096;
constexpr int MP = SEQ, MS = DECB * DECS, MT = MP + MS;
constexpr int RH = 4, RDK = 256, RDV = 256, RW = 1024;
constexpr int MH = 8, QL = 512, KVL = 512, NOPE = 128, ROPE = 64, VH = 128, QKH = 192, MLAW = 1024;
constexpr int NKEYS = 128, NEXP = 16384, PH = 8, PTOPK = 16, PLE = 256;
constexpr int INW = 5184, INWP = 5376;
constexpr float EPS = 1e-6f;
constexpr int CROW = 576;
constexpr float QSCALE = 0.07216878364870322f * 1.4426950408889634f;

constexpr size_t O_Y = 0, O_CKVP = 18874368, O_KRP = 23068672, O_RETP = 23592960, O_CKVS = 23855104, O_KRS = 24379392, O_RETS = 24444928, O_TOTAL = 32833536;
namespace pg8 {
#define PG8_LAS __attribute__((address_space(3)))
typedef unsigned short bf16_t;
typedef short bf16x8 __attribute__((ext_vector_type(8)));
typedef float f32x4 __attribute__((ext_vector_type(4)));
typedef unsigned u32x4 __attribute__((ext_vector_type(4)));
constexpr int BM = 256, BK = 64, HALF = 128, HTB = HALF * BK * 2  , STAGE_BYTES = 8 * HTB, NXCD = 8, WGM = 8;

__host__ __device__ __forceinline__ int lds_byte(int r, int c) { const int st = (r >> 4) * 2 + (c >> 5), rr = r & 15, cc = c & 31, ob = rr * 64 + cc * 2; return st * 1024 + (ob ^ (((ob >> 9) & 1) << 5)); }
__host__ __device__ __forceinline__ void stage_rc(int b, int& R, int& C) { const int st = b / 1024, sb = b % 1024, swz = sb ^ (((sb >> 9) & 1) << 5); R = (st >> 1) * 16 + swz / 64; C = (st & 1) * 32 + (swz % 64) / 2; }
__host__ __device__ __forceinline__ int perm32(int rho) { const int n = rho >> 4, i = rho & 15; return 8 * (i >> 2) + 4 * n + (i & 3); }

struct Unit { int pm, pn; };
struct Gemm { const bf16_t* A; const bf16_t* Bt; int M, N, K; };

struct StaticOrder {
    int nM, nN, nwg, G, c, wv = 0;
    __host__ __device__ void init(int M, int N, int G_, int c_) { nM = M / BM; nN = N / BM; nwg = nM * nN; G = G_; c = c_; }
    __host__ __device__ bool next(int i, Unit& u) const {
        const long L = (long)i * G + c; if (L >= nwg) return false;
        int wgid = (int)L; { const int q = nwg / NXCD, r = nwg % NXCD, xcd = wgid % NXCD, off = wgid / NXCD; wgid = (xcd < r ? xcd * (q + 1) : r * (q + 1) + (xcd - r) * q) + off; }
        const int nig = WGM * nN, gid = wgid / nig, fm = gid * WGM, gsz = (nM - fm) < WGM ? (nM - fm) : WGM;
        u.pm = fm + ((wgid % nig) % gsz); u.pn = (wgid % nig) / gsz; return true;
    }
    __device__ __forceinline__ void a_ready(const Unit&) const {}
    __device__ __forceinline__ void done(const Unit&) const {}
};

__device__ __forceinline__ unsigned cvt_pk_bf16(float lo, float hi) { unsigned r; asm volatile("v_cvt_pk_bf16_f32 %0, %1, %2" : "=v"(r) : "v"(lo), "v"(hi)); return r; }
typedef float f32x2 __attribute__((ext_vector_type(2)));
__device__ __forceinline__ f32x2 gelu_pk(f32x2 v) {
    const f32x2 av = __builtin_elementwise_abs(v), d = av * 0.2316418882f + 1.0f;
    f32x2 t; t.x = __builtin_amdgcn_rcpf(d.x); t.y = __builtin_amdgcn_rcpf(d.y);
    f32x2 q = t * 0.5307027145f + (-0.7265760135f); q = q * t + 0.7107068705f; q = q * t + (-0.142248368f); q = q * t + 0.127414796f; q = q * t;
    const f32x2 s = (v * v) * (-0.72134752044f);
    f32x2 e; e.x = __builtin_amdgcn_exp2f(s.x); e.y = __builtin_amdgcn_exp2f(s.y);
    const f32x2 m = v * (q * e), r = v - m;
    f32x2 o; o.x = v.x < 0.f ? m.x : r.x; o.y = v.y < 0.f ? m.y : r.y; return o;
}

template <int ACT  > struct EpiBf16 {
    static constexpr bool PERM = true, AFTER_DRAIN = false; static_assert(ACT == 0 || ACT == 1, "EpiBf16: ACT is 0 (none) or 1 (gelu_pk)");
    bf16_t* O; int ldc; const float* bias; int split_cols; size_t split_stride; float scale0;
    __device__ __forceinline__ void operator()(const f32x4 (&acc)[2][2][4][2], const Unit& u, int wr, int wc, int fr, int fq) const {
        const int row0 = u.pm * BM + wr * 64 + fr; int colt = u.pn * BM; bf16_t* base = O;
        float sc = 1.f; if (split_cols) { const int t = colt / split_cols; base += (size_t)t * split_stride; colt -= t * split_cols; if (t == 0) sc = scale0; }
        const int col0 = colt + wc * 32 + 8 * fq, bcol0 = u.pn * BM + wc * 32 + 8 * fq;
        f32x4 bv[2][2];
#pragma unroll
        for (int bj = 0; bj < 2; ++bj)
#pragma unroll
            for (int n = 0; n < 2; ++n) bv[bj][n] = bias ? *(const f32x4*)(bias + bcol0 + bj * HALF + 4 * n) : (f32x4){0.f, 0.f, 0.f, 0.f};
#pragma unroll
        for (int ai = 0; ai < 2; ++ai)
#pragma unroll
            for (int m = 0; m < 4; ++m) { bf16_t* rowp = base + (size_t)(row0 + ai * HALF + m * 16) * ldc + col0;
#pragma unroll
                for (int bj = 0; bj < 2; ++bj) { f32x4 v0 = acc[ai][bj][m][0] + bv[bj][0], v1 = acc[ai][bj][m][1] + bv[bj][1];
                    if (ACT == 1) { f32x2 a = gelu_pk((f32x2){v0[0], v0[1]}), b = gelu_pk((f32x2){v0[2], v0[3]}), c = gelu_pk((f32x2){v1[0], v1[1]}), d = gelu_pk((f32x2){v1[2], v1[3]});
                        v0 = (f32x4){a.x, a.y, b.x, b.y}; v1 = (f32x4){c.x, c.y, d.x, d.y}; }
                    v0 = v0 * sc; v1 = v1 * sc; u32x4 w; w.x = cvt_pk_bf16(v0[0], v0[1]); w.y = cvt_pk_bf16(v0[2], v0[3]); w.z = cvt_pk_bf16(v1[0], v1[1]); w.w = cvt_pk_bf16(v1[2], v1[3]);
                    *(u32x4*)(rowp + bj * HALF) = w; } }
    }
};
template <class Epi, class Sched, bool ALIGN_EPI = false, bool SP2 = false>
__device__ __forceinline__ void gemm_phase(PG8_LAS unsigned char* lds, const Gemm g, const Sched& S, const Epi& E) {
    int lane_l; asm volatile("v_mbcnt_lo_u32_b32 %0, -1, 0\n\tv_mbcnt_hi_u32_b32 %0, -1, %0" : "=v"(lane_l)); int tid_l = S.wv * 64 + lane_l; asm volatile("" : "+v"(tid_l));
    const int tid = tid_l, wid = __builtin_amdgcn_readfirstlane(tid >> 6), lane = tid & 63, wr = wid >> 2, wc = wid & 3, fr = lane & 15, fq = lane >> 4;
    const int K = g.K, nt = K / BK;
    unsigned voffA[2], voffB[2];
#pragma unroll
    for (int i = 0; i < 2; ++i) { int R, C; stage_rc(tid * 16 + i * 8192, R, C); const int Rb = Epi::PERM ? ((R & ~31) + perm32(R & 31)) : R;
        voffA[i] = (unsigned)(R * K + C) * 2u; voffB[i] = (unsigned)(Rb * K + C) * 2u; }
    const size_t kstep = (size_t)(BK * 2);
    const size_t hstep = (size_t)HALF * K * 2;
    const size_t tstep = 2 * hstep;
    const unsigned ldsw = (unsigned)wid * 1024u;
    const int aoff = lds_byte(wr * 64 + fr, fq * 8), boff = lds_byte(wc * 32 + fr, fq * 8);
#define PG8_SA(b, h) (((b) * 2 + (h)) * HTB)
#define PG8_SB(b, h) ((4 + (b) * 2 + (h)) * HTB)
#define PG8_STAGE(bufoff, gbase, voff) do { _Pragma("unroll") for (int _i = 0; _i < 2; ++_i) \
        __builtin_amdgcn_global_load_lds((const unsigned*)((const char*)(gbase) + (voff)[_i]), (PG8_LAS unsigned*)(lds + (bufoff) + ldsw + _i * 8192), 16, 0, 0); } while (0)
#define PG8_LDA(dst, b, h) do { _Pragma("unroll") for (int m = 0; m < 4; ++m) _Pragma("unroll") for (int k = 0; k < 2; ++k) dst[m][k] = *(const PG8_LAS bf16x8*)(lds + PG8_SA(b, h) + aoff + m * 2048 + k * 1024); } while (0)
#define PG8_LDB(dst, b, h) do { _Pragma("unroll") for (int n = 0; n < 2; ++n) _Pragma("unroll") for (int k = 0; k < 2; ++k) dst[n][k] = *(const PG8_LAS bf16x8*)(lds + PG8_SB(b, h) + boff + n * 2048 + k * 1024); } while (0)
#define PG8_MMA(ai, bj, At, Bt) do { __builtin_amdgcn_s_setprio(1); _Pragma("unroll") for (int m = 0; m < 4; ++m) _Pragma("unroll") for (int n = 0; n < 2; ++n) _Pragma("unroll") for (int k = 0; k < 2; ++k) \
        acc[ai][bj][m][n] = __builtin_amdgcn_mfma_f32_16x16x32_bf16(Bt[n][k], At[m][k], acc[ai][bj][m][n], 0, 0, 0); __builtin_amdgcn_s_setprio(0); } while (0)
#define PG8_WAIT_V(n) asm volatile("s_waitcnt vmcnt(" #n ")" ::: "memory")
#define PG8_WAIT_L(n) asm volatile("s_waitcnt lgkmcnt(" #n ")" ::: "memory")
#define PG8_BAR __builtin_amdgcn_s_barrier()
#define PG8_SCHED __builtin_amdgcn_sched_barrier(0)
    Unit cur, nxt; int ui = 0;
    if (!S.next(0, cur)) return;
    f32x4 acc[2][2][4][2];
#pragma unroll
    for (int a = 0; a < 2; ++a)
#pragma unroll
        for (int b = 0; b < 2; ++b)
#pragma unroll
            for (int m = 0; m < 4; ++m)
#pragma unroll
                for (int n = 0; n < 2; ++n) acc[a][b][m][n] = (f32x4){0.f, 0.f, 0.f, 0.f};
    bf16x8 At[4][2], B0[2][2], B1[2][2];
    const char* cA = (const char*)g.A + (size_t)cur.pm * tstep; const char* cB = (const char*)g.Bt + (size_t)cur.pn * tstep;
    S.a_ready(cur);
    if constexpr (SP2) {
        PG8_STAGE(PG8_SB(0, 0), cB, voffB); PG8_STAGE(PG8_SB(0, 1), cB + hstep, voffB); PG8_STAGE(PG8_SA(0, 0), cA, voffA); PG8_STAGE(PG8_SA(0, 1), cA + hstep, voffA);
        if (wr == 1) PG8_BAR;
        PG8_WAIT_V(2); PG8_BAR;
        PG8_STAGE(PG8_SB(1, 0), cB + kstep, voffB); PG8_STAGE(PG8_SA(1, 0), cA + kstep, voffA); PG8_STAGE(PG8_SB(1, 1), cB + hstep + kstep, voffB);
        PG8_WAIT_V(6); PG8_BAR;
    } else {
        PG8_STAGE(PG8_SB(0, 0), cB, voffB); PG8_STAGE(PG8_SA(0, 0), cA, voffA); PG8_STAGE(PG8_SB(0, 1), cB + hstep, voffB); PG8_STAGE(PG8_SA(0, 1), cA + hstep, voffA);
        if (wr == 1) PG8_BAR;
        PG8_WAIT_V(4); PG8_BAR;
        PG8_STAGE(PG8_SB(1, 0), cB + kstep, voffB); PG8_STAGE(PG8_SA(1, 0), cA + kstep, voffA); PG8_STAGE(PG8_SB(1, 1), cB + hstep + kstep, voffB);
        PG8_WAIT_V(6); PG8_BAR;
    }
    for (;;) {
        const bool has_next = S.next(ui + 1, nxt);
        const char* nA = has_next ? (const char*)g.A + (size_t)nxt.pm * tstep : cA; const char* nB = has_next ? (const char*)g.Bt + (size_t)nxt.pn * tstep : cB;
        for (int t = 0; t < nt; t += 2) {
            const bool last = (t == nt - 2);
            const char* a1 = cA + (size_t)(t + 1) * kstep;
            const char* a2 = last ? nA : cA + (size_t)(t + 2) * kstep; const char* b2 = last ? nB : cB + (size_t)(t + 2) * kstep;
            const char* a3 = a2 + kstep; const char* b3 = b2 + kstep;
            if (last && has_next) S.a_ready(nxt);
            if constexpr (SP2) {
            PG8_LDB(B0, 0, 0); PG8_LDB(B1, 0, 1); PG8_SCHED; PG8_LDA(At, 0, 0); PG8_STAGE(PG8_SA(1, 1), a1 + hstep, voffA);
            PG8_WAIT_V(8); PG8_WAIT_L(0); PG8_BAR; PG8_MMA(0, 0, At, B0); PG8_MMA(0, 1, At, B1); PG8_BAR; PG8_SCHED;
            PG8_LDA(At, 0, 1); PG8_STAGE(PG8_SB(0, 0), b2, voffB); PG8_STAGE(PG8_SB(0, 1), b2 + hstep, voffB); PG8_STAGE(PG8_SA(0, 0), a2, voffA);
            PG8_WAIT_V(8); PG8_WAIT_L(0); PG8_BAR; PG8_MMA(1, 0, At, B0); PG8_MMA(1, 1, At, B1); PG8_BAR; PG8_SCHED;
            PG8_LDB(B0, 1, 0); PG8_LDB(B1, 1, 1); PG8_SCHED; PG8_LDA(At, 1, 0); PG8_STAGE(PG8_SA(0, 1), a2 + hstep, voffA);
            PG8_WAIT_V(8); PG8_WAIT_L(0); PG8_BAR; PG8_MMA(0, 0, At, B0); PG8_MMA(0, 1, At, B1); PG8_BAR; PG8_SCHED;
            PG8_LDA(At, 1, 1); PG8_STAGE(PG8_SB(1, 0), b3, voffB); PG8_STAGE(PG8_SB(1, 1), b3 + hstep, voffB); PG8_STAGE(PG8_SA(1, 0), a3, voffA);
            PG8_WAIT_V(8); PG8_WAIT_L(0); PG8_BAR; PG8_MMA(1, 0, At, B0); PG8_MMA(1, 1, At, B1); PG8_BAR; PG8_SCHED;
            } else {
            PG8_LDB(B0, 0, 0); PG8_SCHED; PG8_LDA(At, 0, 0); PG8_STAGE(PG8_SA(1, 1), a1 + hstep, voffA);
            PG8_WAIT_L(8); PG8_BAR; PG8_WAIT_L(0); PG8_MMA(0, 0, At, B0); PG8_BAR; PG8_SCHED;
            PG8_LDB(B1, 0, 1); PG8_STAGE(PG8_SB(0, 0), b2, voffB);
            PG8_BAR; PG8_WAIT_L(0); PG8_MMA(0, 1, At, B1); PG8_BAR;
            PG8_LDA(At, 0, 1); PG8_STAGE(PG8_SA(0, 0), a2, voffA);
            PG8_BAR; PG8_WAIT_L(0); PG8_MMA(1, 0, At, B0); PG8_BAR; PG8_SCHED;
            PG8_STAGE(PG8_SB(0, 1), b2 + hstep, voffB);
            PG8_WAIT_V(6); PG8_BAR; PG8_MMA(1, 1, At, B1); PG8_BAR;
            PG8_LDB(B0, 1, 0); PG8_SCHED; PG8_LDA(At, 1, 0); PG8_STAGE(PG8_SA(0, 1), a2 + hstep, voffA);
            PG8_WAIT_L(8); PG8_BAR; PG8_WAIT_L(0); PG8_MMA(0, 0, At, B0); PG8_BAR; PG8_SCHED;
            PG8_LDB(B1, 1, 1); PG8_STAGE(PG8_SB(1, 0), b3, voffB);
            PG8_BAR; PG8_WAIT_L(0); PG8_MMA(0, 1, At, B1); PG8_BAR;
            PG8_LDA(At, 1, 1); PG8_STAGE(PG8_SA(1, 0), a3, voffA);
            PG8_BAR; PG8_WAIT_L(0); PG8_MMA(1, 0, At, B0); PG8_BAR; PG8_SCHED;
            PG8_STAGE(PG8_SB(1, 1), b3 + hstep, voffB);
            PG8_WAIT_V(6); PG8_BAR; PG8_MMA(1, 1, At, B1); PG8_BAR;
            }
        }
        if constexpr (ALIGN_EPI) { if (wr == 0) PG8_BAR; }
        if constexpr (!Epi::AFTER_DRAIN) { E(acc, cur, wr, wc, fr, fq); S.done(cur); }
        if (!has_next) break;
#pragma unroll
        for (int a = 0; a < 2; ++a)
#pragma unroll
            for (int b = 0; b < 2; ++b)
#pragma unroll
                for (int m = 0; m < 4; ++m)
#pragma unroll
                    for (int n = 0; n < 2; ++n) acc[a][b][m][n] = (f32x4){0.f, 0.f, 0.f, 0.f};
        cur = nxt; cA = nA; cB = nB; ++ui;
        if constexpr (ALIGN_EPI) { if (wr == 1) PG8_BAR; }
    }
    PG8_WAIT_V(0);
    if constexpr (!ALIGN_EPI) { if (wr == 0) PG8_BAR; }
    PG8_BAR;
    if constexpr (Epi::AFTER_DRAIN) { E.fused(acc, cur, wr, wc, fr, fq, lds, wid, lane); S.done(cur); }
#undef PG8_SA
#undef PG8_SB
#undef PG8_STAGE
#undef PG8_LDA
#undef PG8_LDB
#undef PG8_MMA
#undef PG8_WAIT_V
#undef PG8_WAIT_L
#undef PG8_BAR
#undef PG8_SCHED
}
}

#define LAS __attribute__((address_space(3)))
typedef unsigned short bf16_t;
typedef short bf16x8 __attribute__((ext_vector_type(8)));
typedef short s16x4 __attribute__((ext_vector_type(4)));
typedef float f32x4 __attribute__((ext_vector_type(4)));
typedef float f32x2 __attribute__((ext_vector_type(2)));
typedef unsigned u32x4 __attribute__((ext_vector_type(4)));
typedef unsigned u32x2 __attribute__((ext_vector_type(2)));
#define LDS_WAIT() asm volatile("s_waitcnt lgkmcnt(0)" ::: "memory")
#define VM_WAIT() asm volatile("s_waitcnt vmcnt(0)" ::: "memory")
constexpr int NWAVES = 8, NTHR = 512;
__device__ __forceinline__ int lane_id() { int l; asm volatile("v_mbcnt_lo_u32_b32 %0, -1, 0\n\tv_mbcnt_hi_u32_b32 %0, -1, %0" : "=v"(l)); return l; }

typedef __bf16 bf16x2_t __attribute__((ext_vector_type(2)));
__device__ __forceinline__ unsigned pk2(float lo, float hi) { const f32x2 v = {lo, hi}; return __builtin_bit_cast(unsigned, __builtin_convertvector(v, bf16x2_t)); }
__device__ __forceinline__ bf16_t f2bf(float f) { return (bf16_t)(pk2(f, 0.f) & 0xffffu); }
__device__ __forceinline__ float bf2f(unsigned h) { return __uint_as_float(h << 16); }
__device__ __forceinline__ float bflo(unsigned w) { return __uint_as_float(w << 16); }
__device__ __forceinline__ float bfhi(unsigned w) { return __uint_as_float(w & 0xffff0000u); }
template <int CTRL> __device__ __forceinline__ float dppf(float v) { return __builtin_bit_cast(float, __builtin_amdgcn_update_dpp(0, __builtin_bit_cast(int, v), CTRL, 0xf, 0xf, true)); }
__device__ __forceinline__ float wave_sum(float v) {
    v += dppf<0xB1>(v); v += dppf<0x4E>(v); v += dppf<0x141>(v); v += dppf<0x140>(v);
    const float s0 = __builtin_bit_cast(float, __builtin_amdgcn_readlane(__builtin_bit_cast(int, v), 0)), s1 = __builtin_bit_cast(float, __builtin_amdgcn_readlane(__builtin_bit_cast(int, v), 16));
    const float s2 = __builtin_bit_cast(float, __builtin_amdgcn_readlane(__builtin_bit_cast(int, v), 32)), s3 = __builtin_bit_cast(float, __builtin_amdgcn_readlane(__builtin_bit_cast(int, v), 48));
    return (s0 + s1) + (s2 + s3);
}
__device__ __forceinline__ float quad4_total(float d0, float d1, float d2, float d3, bool b0, bool b1) {
    const float v01 = (b0 ? d1 : d0) + dppf<0xB1>(b0 ? d0 : d1), v23 = (b0 ? d3 : d2) + dppf<0xB1>(b0 ? d2 : d3);
    float v = (b1 ? v23 : v01) + dppf<0x4E>(b1 ? v01 : v23);
    v += dppf<0x124>(v); v += dppf<0x128>(v);
    { const auto r = __builtin_amdgcn_permlane16_swap(__builtin_bit_cast(unsigned, v), __builtin_bit_cast(unsigned, v), false, false); v = __builtin_bit_cast(float, (unsigned)r[0]) + __builtin_bit_cast(float, (unsigned)r[1]); }
    { const auto r = __builtin_amdgcn_permlane32_swap(__builtin_bit_cast(unsigned, v), __builtin_bit_cast(unsigned, v), false, false); v = __builtin_bit_cast(float, (unsigned)r[0]) + __builtin_bit_cast(float, (unsigned)r[1]); }
    return v;
}
__device__ __forceinline__ float wave_max(float v) {
#pragma unroll
    for (int o = 1; o < 64; o <<= 1) v = fmaxf(v, __shfl_xor(v, o));
    return v;
}
__device__ __forceinline__ f32x4 mfma16(bf16x8 a, bf16x8 b, f32x4 c) { return __builtin_amdgcn_mfma_f32_16x16x32_bf16(a, b, c, 0, 0, 0); }
__device__ __forceinline__ bf16x8 pack8(f32x4 a, f32x4 b) {
    u32x4 w; w.x = pk2(a[0], a[1]); w.y = pk2(a[2], a[3]); w.z = pk2(b[0], b[1]); w.w = pk2(b[2], b[3]);
    return __builtin_bit_cast(bf16x8, w);
}
__device__ __forceinline__ bf16x8 cvt8(const float* p) {
    const f32x4 a = *(const f32x4*)p, b = *(const f32x4*)(p + 4);
    return pack8(a, b);
}
__device__ __forceinline__ float lg2gamma(int h) { return h == 0 ? -0.04580368961312479f : h == 1 ? -0.01800355292833101f : h == 2 ? -0.007117849617096998f : -0.002820519062378663f; }

struct Prm {
    const float* in[26];
    float* out;
    unsigned* CTL;
    bf16_t *WinT, *WuqT, *WukT, *WuvTg, *WuvT, *WukN, *WoutT, *WsT, *WgT, *WpT; unsigned char *U8, *V8; float *US, *VS;
    f32x2 *tabR, *tab64;
    bf16_t *XN, *Pb, *RQ, *RK, *RKt, *RVt, *RG, *ZCQ, *ZCKV, *KRb, *CKVNs, *Q, *KN, *VTp, *PP, *CACHE, *S0T, *SPREV, *ACat, *PARTO; f32x2* PARTML;
    float *ssq1, *OINTRA, *KVp, *H1, *ssq2, *SC, *ssq3;
};
__device__ __forceinline__ const float* xrow(const Prm& p, int row) { return row < MP ? p.in[0] + (size_t)row * DM : p.in[1] + (size_t)(row - MP) * DM; }
__device__ __forceinline__ int rowpos(int row) { return row < MP ? row : PAST + ((row - MP) & 31); }
#define XB_TMO      128
#define XB_XCNT(j)  (256  + 64 * (j))
#define XB_XSUB(j)  (1280 + 64 * (j))
#define XB_XGEN(j)  (2304 + 64 * (j))
#define XB_TOP      3328
#define XB_TOPGEN   3392
#define XCD_BAR_WORDS 3456
#define XB_SPIN_CAP (1u << 18)

__device__ __forceinline__ unsigned xb_ld(unsigned* p)              { return __hip_atomic_load(p, __ATOMIC_RELAXED, __HIP_MEMORY_SCOPE_AGENT); }
__device__ __forceinline__ unsigned xb_add(unsigned* p, unsigned v) { return __hip_atomic_fetch_add(p, v, __ATOMIC_RELAXED, __HIP_MEMORY_SCOPE_AGENT); }
__device__ __forceinline__ unsigned xb_xcc_id() { return (unsigned)__builtin_amdgcn_s_getreg((3 << 11) | 20) & 0xFu; }
#define XB_SPIN(cond, bar) do { unsigned _sp = 0; while (cond) { __builtin_amdgcn_s_sleep(1); \
    if ((++_sp & 255u) == 0u) { if (xb_ld(&(bar)[XB_TMO])) break; if (_sp > XB_SPIN_CAP) { atomicAdd(&(bar)[XB_TMO], 1u); break; } } } } while (0)

__device__ __forceinline__ int xb_lane() { int l; asm volatile("v_mbcnt_lo_u32_b32 %0, -1, 0\n\tv_mbcnt_hi_u32_b32 %0, -1, %0" : "=v"(l)); return l; }
struct XcdBarrier {
    unsigned* bar; unsigned x;
    volatile LAS unsigned* st; bool w0;
};

__device__ __forceinline__ XcdBarrier xcd_barrier_post(unsigned* bar, volatile LAS unsigned* st, bool w0) {
    XcdBarrier b; b.bar = bar; b.x = xb_xcc_id(); b.st = st; b.w0 = w0;
    if (w0 && xb_lane() == 0) (void)xb_add(&bar[XB_XCNT(b.x)], 1u);
    return b;
}
__device__ __forceinline__ void xcd_barrier_complete(unsigned* bar, unsigned x, unsigned& nloc, unsigned& nx) {
    const unsigned G = gridDim.x * gridDim.y * gridDim.z;
    unsigned sum, cnt, mine, sp = 0u;
    for (;;) {
        sum = 0u; cnt = 0u; mine = 0u;
#pragma unroll
        for (unsigned j = 0; j < 16; ++j) { const unsigned c = xb_ld(&bar[XB_XCNT(j)]); sum += c; cnt += (c > 0u) ? 1u : 0u; mine = (j == x) ? c : mine; }
        if (sum == G) break;
        __builtin_amdgcn_s_sleep(1);
        if ((++sp & 255u) == 0u) { if (xb_ld(&bar[XB_TMO])) break; if (sp > XB_SPIN_CAP) { atomicAdd(&bar[XB_TMO], 1u); break; } }
    }
    nloc = mine > 0u ? mine : 1u; nx = cnt > 0u ? cnt : 1u;
}

__device__ __forceinline__ void xcd_barrier(const XcdBarrier& b) {
    asm volatile("s_waitcnt vmcnt(0)" ::: "memory");
    __syncthreads();
    if (b.w0 && xb_lane() == 0) {
        unsigned* bar = b.bar;
        __builtin_amdgcn_s_waitcnt(0);
        unsigned nloc = b.st[0], nx = b.st[1];
        if (nloc == 0u) { xcd_barrier_complete(bar, b.x, nloc, nx); b.st[0] = nloc; b.st[1] = nx; }
        const unsigned old = xb_add(&bar[XB_XSUB(b.x)], 1u);
        const unsigned gen = old / nloc;
        if (old + 1u == (gen + 1u) * nloc) {
            __builtin_amdgcn_fence(__ATOMIC_RELEASE, "agent");
            asm volatile("s_waitcnt vmcnt(0)" ::: "memory");
            const unsigned og = xb_add(&bar[XB_TOP], 1u);
            const unsigned tg = og / nx;
            if (og + 1u == (tg + 1u) * nx) xb_add(&bar[XB_TOPGEN], 1u);
            else XB_SPIN(xb_ld(&bar[XB_TOPGEN]) == tg, bar);
            __builtin_amdgcn_fence(__ATOMIC_ACQUIRE, "agent");
            xb_add(&bar[XB_XGEN(b.x)], 1u);
            asm volatile("s_waitcnt vmcnt(0)" ::: "memory");
        } else {
            XB_SPIN(xb_ld(&bar[XB_XGEN(b.x)]) == gen, bar);
            __builtin_amdgcn_fence(__ATOMIC_ACQUIRE, "agent");
            asm volatile("s_waitcnt vmcnt(0)" ::: "memory");
        }
    }
    __syncthreads();
}

__device__ __forceinline__ void tr_item(const float* __restrict__ W, size_t ldw, int k0, int n0, bf16_t* WT, size_t ldt, int drow0, int dcol0, const float* kscale, LAS float* scr, int lane) {
#pragma unroll 8
    for (int i = 0; i < 32; ++i) { const int kk = 2 * i + (lane >> 5); float v = W[(size_t)(k0 + kk) * ldw + n0 + (lane & 31)]; if (kscale) v *= kscale[k0 + kk]; scr[kk * 33 + (lane & 31)] = v; }
    LDS_WAIT(); asm volatile("" ::: "memory");
    const int c = lane & 7;
#pragma unroll
    for (int j = 0; j < 4; ++j) { const int n = (lane >> 3) + 8 * j; const LAS float* s = scr + (8 * c) * 33 + n;
        u32x4 o; o.x = pk2(s[0 * 33], s[1 * 33]); o.y = pk2(s[2 * 33], s[3 * 33]); o.z = pk2(s[4 * 33], s[5 * 33]); o.w = pk2(s[6 * 33], s[7 * 33]);
        *(u32x4*)(WT + (size_t)(drow0 + n) * ldt + dcol0 + 8 * c) = o; }
    LDS_WAIT(); asm volatile("" ::: "memory");
}
__device__ __forceinline__ void cvt8_store(const float* src, bf16_t* dst) {
    const f32x4 a = *(const f32x4*)src, b = *(const f32x4*)(src + 4);
    u32x4 w; w.x = pk2(a[0], a[1]); w.y = pk2(a[2], a[3]); w.z = pk2(b[0], b[1]); w.w = pk2(b[2], b[3]);
    *(u32x4*)dst = w;
}
typedef float f32x16 __attribute__((ext_vector_type(16)));
typedef float f32x32 __attribute__((ext_vector_type(32)));
typedef unsigned u32x6 __attribute__((ext_vector_type(6)));
constexpr int EROW = 1024;
__device__ __forceinline__ void expert_tables_fp8(const Prm& p, int gw, int NGW, int lane) {
    for (int row = gw; row < 2 * NEXP; row += NGW) {
        const bool isv = row >= NEXP; const int r = row & (NEXP - 1);
        const float* src = (isv ? p.in[21] : p.in[20]) + (size_t)r * DM + lane * 32;
        f32x4 v[8]; float mx = 0.f;
#pragma unroll
        for (int q = 0; q < 8; ++q) { v[q] = *(const f32x4*)(src + q * 4); const f32x4 a = v[q];
            mx = fmaxf(mx, fmaxf(fmaxf(fabsf(a.x), fabsf(a.y)), fmaxf(fabsf(a.z), fabsf(a.w)))); }
        mx = wave_max(mx);
        const float inv = mx > 0.f ? 6.0f / mx : 0.f;
        u32x4 pk;
#pragma unroll
        for (int d = 0; d < 4; ++d) { unsigned w = 0u;
            w = __builtin_amdgcn_cvt_scalef32_pk_fp4_f32(w, v[2 * d][0] * inv, v[2 * d][1] * inv, 1.0f, 0);
            w = __builtin_amdgcn_cvt_scalef32_pk_fp4_f32(w, v[2 * d][2] * inv, v[2 * d][3] * inv, 1.0f, 1);
            w = __builtin_amdgcn_cvt_scalef32_pk_fp4_f32(w, v[2 * d + 1][0] * inv, v[2 * d + 1][1] * inv, 1.0f, 2);
            w = __builtin_amdgcn_cvt_scalef32_pk_fp4_f32(w, v[2 * d + 1][2] * inv, v[2 * d + 1][3] * inv, 1.0f, 3);
            pk[d] = w; }
        *(u32x4*)((isv ? p.V8 : p.U8) + (size_t)r * EROW + lane * 16) = pk;
        if (lane == 0) (isv ? p.VS : p.US)[r] = mx * (1.f / 6.0f);
    }
}
template <int M0 = 255> __device__ __forceinline__ void phase0(const Prm& p, LAS unsigned char* lds, int tid, int lane, int wave) {
    LAS float* scr = (LAS float*)(lds + wave * 8704);
    const int gw = blockIdx.x * NWAVES + wave, NGW = gridDim.x * NWAVES;
    const long gt = (long)blockIdx.x * NTHR + tid, NGT = (long)gridDim.x * NTHR;
    constexpr int I_IN = 32 * 162, I_UQ = 8 * 48, I_UK = 8 * 32, I_OUT = 32 * 64, I_PROJ = 4 * 64, I_S0 = 128 * 32;
    constexpr int NIT = I_IN + I_UQ + 3 * I_UK + 2 * I_OUT + I_PROJ + I_S0;
    if (M0 & 1) for (int it = gw; it < NIT; it += NGW) {
        int r = it;
        if (r < I_IN) { const int kb = r / 162, nb = r % 162, n0 = nb * 32; int drow = n0; if (n0 >= 5120) drow = (n0 == 5120) ? 5120 : 5120 + 128;
            tr_item(p.in[8], INW, kb * 64, n0, p.WinT, DM, drow, kb * 64, nullptr, scr, lane); continue; } r -= I_IN;
        if (r < I_UQ) { const int kb = r / 48, nb = r % 48, n0 = nb * 32, h = n0 / 192, d = n0 % 192; int drow;
            if (d < 128) drow = h * 128 + d; else drow = 1024 + (h >> 2) * 256 + (d >= 160 ? 128 : 0) + (h & 3) * 32;
            tr_item(p.in[10], 1536, kb * 64, n0, p.WuqT, QL, drow, kb * 64, p.in[9], scr, lane); continue; } r -= I_UQ;
        if (r < I_UK) { const int kb = r / 32, nb = r % 32; tr_item(p.in[12], 1024, kb * 64, nb * 32, p.WukT, KVL, nb * 32, kb * 64, p.in[11], scr, lane); continue; } r -= I_UK;
        if (r < I_UK) { const int kb = r / 32, nb = r % 32; tr_item(p.in[13], 1024, kb * 64, nb * 32, p.WuvTg, KVL, nb * 32, kb * 64, p.in[11], scr, lane); continue; } r -= I_UK;
        if (r < I_UK) { const int kb = r / 32, nb = r % 32; tr_item(p.in[13], 1024, kb * 64, nb * 32, p.WuvT, KVL, nb * 32, kb * 64, nullptr, scr, lane); continue; } r -= I_UK;
        if (r < I_OUT) { const int kb = r / 64, nb = r % 64; tr_item(p.in[16], DM, kb * 64, nb * 32, p.WoutT, DM, nb * 32, kb * 64, nullptr, scr, lane); continue; } r -= I_OUT;
        if (r < I_OUT) { const int kb = r / 64, nb = r % 64; tr_item(p.in[23], DM, kb * 64, nb * 32, p.WgT, DM, nb * 32, kb * 64, nullptr, scr, lane); continue; } r -= I_OUT;
        if (r < I_PROJ) { const int kb = r / 64, nb = r % 64; tr_item(p.in[24], DM, kb * 64, nb * 32, p.WpT, PLE, nb * 32, kb * 64, nullptr, scr, lane); continue; } r -= I_PROJ;
        { const int mat = r / 32, q = r % 32, kb = q / 8, nb = q % 8;
          tr_item(p.in[4] + (size_t)mat * 65536, 256, kb * 64, nb * 32, p.S0T + (size_t)mat * 65536, 256, nb * 32, kb * 64, nullptr, scr, lane); }
    }
    if (M0 & 2) for (int it = gw; it < 16 * 128; it += NGW) {
        const int g = it >> 7, k0 = (it & 127) * 16, fr = lane & 15, fq = lane >> 4;
        const float* wq = p.in[18] + (size_t)(k0 + fr) * DM + g * 128 + 8 * fq;
        bf16x8 yf[4];
#pragma unroll
        for (int ds = 0; ds < 4; ++ds) yf[ds] = cvt8(wq + 32 * ds);
        const float* sk = p.in[19] + (size_t)g * 16384 + (size_t)fr * 128 + 8 * fq;
        for (int kb = 0; kb < 8; ++kb) {
            f32x4 acc = {0.f, 0.f, 0.f, 0.f};
#pragma unroll
            for (int ds = 0; ds < 4; ++ds) acc = mfma16(cvt8(sk + (size_t)kb * 2048 + 32 * ds), yf[ds], acc);
#pragma unroll
            for (int rg = 0; rg < 4; ++rg) p.WsT[(size_t)(g * 128 + 16 * kb + 4 * fq + rg) * DM + k0 + fr] = f2bf(acc[rg]);
        }
    }
    for (long i = gt; i < 65536; i += NGT) cvt8_store(p.in[12] + i * 8, p.WukN + i * 8);
    for (long i = gt; i < (long)MT * 32; i += NGT) { const long row = i >> 5, c = (i & 31) * 8;
        const float* src = row < MP ? p.in[5] + row * PLE + c : p.in[6] + (row - MP) * PLE + c; cvt8_store(src, p.Pb + row * PLE + c); }
    if (M0 & 8) for (long i0 = gt; i0 < (long)DECB * PAST * 72; i0 += 4 * NGT) {
        f32x4 a[4], b[4]; long rw[4]; int c[4];
#pragma unroll
        for (int q = 0; q < 4; ++q) { const long i = i0 + q * NGT; rw[q] = i / 72; c[q] = (int)(i % 72);
            const float* src = c[q] < 64 ? p.in[2] + rw[q] * KVL + c[q] * 8 : p.in[3] + rw[q] * ROPE + (c[q] - 64) * 8;
            if (i < (long)DECB * PAST * 72) { a[q] = __builtin_nontemporal_load((const f32x4*)src); b[q] = __builtin_nontemporal_load((const f32x4*)(src + 4)); } }
#pragma unroll
        for (int q = 0; q < 4; ++q) if (i0 + q * NGT < (long)DECB * PAST * 72)
            *(u32x4*)(p.CACHE + rw[q] * CROW + c[q] * 8) = (u32x4){pk2(a[q][0], a[q][1]), pk2(a[q][2], a[q][3]), pk2(b[q][0], b[q][1]), pk2(b[q][2], b[q][3])};
    }
    for (long i = gt; i < 192 * 256; i += NGT) { const int rr = (int)(i >> 8), c = (int)(i & 255) * 8; const int row = 5120 + (rr < 96 ? 32 + rr : 160 + (rr - 96));
        *(u32x4*)(p.WinT + (size_t)row * DM + c) = (u32x4){0u, 0u, 0u, 0u}; }
    if (M0 & 16) for (long i = gt; i < (long)SEQ * 160; i += NGT) {
        const int pos = (int)(i / 160), j = (int)(i % 160); const bool big = j < 128; const int ii = big ? j : j - 128;
        const double ex = -(double)(2 * ii) / (big ? 256.0 : 64.0) * 13.287712379549449;
        const double inv = exp2(ex); double rev = (double)pos * inv * 0.15915494309189535; rev -= floor(rev);
        const float fr = (float)rev; f32x2 cs; cs.x = __builtin_amdgcn_cosf(fr); cs.y = __builtin_amdgcn_sinf(fr);
        if (big) p.tabR[(size_t)pos * 128 + ii] = cs; else p.tab64[(size_t)pos * 32 + ii] = cs;
    }
    if (M0 & 32) for (int row = gw; row < MT; row += NGW) {
        const f32x4* xr = (const f32x4*)xrow(p, row) + lane; const f32x4* gr = (const f32x4*)p.in[7] + lane;
        f32x4 v[8]; float s = 0.f;
#pragma unroll
        for (int j = 0; j < 8; ++j) { v[j] = xr[64 * j]; s += (v[j].x * v[j].x + v[j].y * v[j].y) + (v[j].z * v[j].z + v[j].w * v[j].w); }
        const float r = rsqrtf(wave_sum(s) * (1.f / DM) + EPS);
        u32x2* o = (u32x2*)(p.XN + (size_t)row * DM) + lane;
#pragma unroll
        for (int j = 0; j < 8; ++j) { const f32x4 g = gr[64 * j]; u32x2 w; w.x = pk2(v[j].x * r * g.x, v[j].y * r * g.y); w.y = pk2(v[j].z * r * g.z, v[j].w * r * g.w); o[64 * j] = w; }
    }
}

struct EpiZ {
    static constexpr bool PERM = true, AFTER_DRAIN = false;
    Prm p;
    __device__ __forceinline__ void operator()(const f32x4 (&acc)[2][2][4][2], const pg8::Unit& u, int wr, int wc, int fr, int fq) const {
        const int pn = u.pn; const bool samp = u.pm >= 32; const int ci = 32 * wc + 8 * fq;
#pragma unroll
        for (int ai = 0; ai < 2; ++ai)
#pragma unroll
            for (int m = 0; m < 4; ++m) {
                const int row = u.pm * 256 + ai * 128 + wr * 64 + m * 16 + fr; const int pos = rowpos(row);
                if (pn < 8) {
                    const int head = pn & 3; const bool isk = pn >= 4;
                    const f32x4* tb = (const f32x4*)(p.tabR + (size_t)pos * 128 + ci);
                    float y1[8], y2[8];
#pragma unroll
                    for (int n = 0; n < 2; ++n) { const f32x4 t0 = tb[2 * n], t1 = tb[2 * n + 1]; const f32x4 x1 = acc[ai][0][m][n], x2 = acc[ai][1][m][n];
                        const float cs[4] = {t0.x, t0.z, t1.x, t1.z}, sn[4] = {t0.y, t0.w, t1.y, t1.w};
#pragma unroll
                        for (int e = 0; e < 4; ++e) { y1[4 * n + e] = x1[e] * cs[e] - x2[e] * sn[e]; y2[4 * n + e] = x2[e] * cs[e] + x1[e] * sn[e]; } }
                    if (isk) {
#pragma unroll
                        for (int e = 0; e < 8; ++e) { y1[e] *= 0.0625f; y2[e] *= 0.0625f; } }
                    bf16_t* dst = (isk ? p.RK : p.RQ) + (size_t)row * RW + head * 256 + ci;
                    *(u32x4*)dst = (u32x4){pk2(y1[0], y1[1]), pk2(y1[2], y1[3]), pk2(y1[4], y1[5]), pk2(y1[6], y1[7])};
                    *(u32x4*)(dst + 128) = (u32x4){pk2(y2[0], y2[1]), pk2(y2[2], y2[3]), pk2(y2[4], y2[5]), pk2(y2[6], y2[7])};
                    if (isk) {
                        const int l = samp ? ((row - MP) & 31) : (row & 63); const int L1 = samp ? 31 : 63;
                        const float kd = __builtin_amdgcn_exp2f((float)(L1 - l) * lg2gamma(head));
                        bf16_t* dt = p.RKt + (size_t)(head * 256 + ci) * MT + row;
#pragma unroll
                        for (int e = 0; e < 8; ++e) { dt[(size_t)e * MT] = f2bf(y1[e] * kd); dt[(size_t)(128 + e) * MT] = f2bf(y2[e] * kd); }
                    }
                } else if (pn < 12) {
                    const int head = pn - 8;
#pragma unroll
                    for (int bj = 0; bj < 2; ++bj)
#pragma unroll
                        for (int n = 0; n < 2; ++n)
#pragma unroll
                            for (int e = 0; e < 4; ++e) p.RVt[(size_t)(head * 256 + 128 * bj + ci + 4 * n + e) * MT + row] = f2bf(acc[ai][bj][m][n][e]);
                } else if (pn < 20) {
                    bf16_t* dst = pn < 16 ? p.RG + (size_t)row * RW + (pn - 12) * 256 : (pn < 18 ? p.ZCQ : p.ZCKV) + (size_t)row * 512 + ((pn - 16) & 1) * 256;
                    float s = 0.f;
#pragma unroll
                    for (int bj = 0; bj < 2; ++bj) { const f32x4 a = acc[ai][bj][m][0], b = acc[ai][bj][m][1];
                        *(u32x4*)(dst + 128 * bj + ci) = (u32x4){pk2(a[0], a[1]), pk2(a[2], a[3]), pk2(b[0], b[1]), pk2(b[2], b[3])};
                        s += (a[0] * a[0] + a[1] * a[1]) + (a[2] * a[2] + a[3] * a[3]) + (b[0] * b[0] + b[1] * b[1]) + (b[2] * b[2] + b[3] * b[3]); }
                    if (pn >= 16) { s += __shfl_xor(s, 16); s += __shfl_xor(s, 32); if (fq == 0) p.ssq1[(size_t)row * 16 + (pn - 16) * 4 + wc] = s; }
                } else if (wc == 0) {
                    const f32x4* tb = (const f32x4*)(p.tab64 + (size_t)pos * 32 + 8 * fq);
                    float y1[8], y2[8];
#pragma unroll
                    for (int n = 0; n < 2; ++n) { const f32x4 t0 = tb[2 * n], t1 = tb[2 * n + 1]; const f32x4 x1 = acc[ai][0][m][n], x2 = acc[ai][1][m][n];
                        const float cs[4] = {t0.x, t0.z, t1.x, t1.z}, sn[4] = {t0.y, t0.w, t1.y, t1.w};
#pragma unroll
                        for (int e = 0; e < 4; ++e) { y1[4 * n + e] = x1[e] * cs[e] - x2[e] * sn[e]; y2[4 * n + e] = x2[e] * cs[e] + x1[e] * sn[e]; } }
                    float* of = samp ? p.out + O_KRS + (size_t)(row - MP) * 64 + 8 * fq : p.out + O_KRP + (size_t)row * 64 + 8 * fq;
                    *(f32x4*)of = (f32x4){y1[0], y1[1], y1[2], y1[3]}; *(f32x4*)(of + 4) = (f32x4){y1[4], y1[5], y1[6], y1[7]};
                    *(f32x4*)(of + 32) = (f32x4){y2[0], y2[1], y2[2], y2[3]}; *(f32x4*)(of + 36) = (f32x4){y2[4], y2[5], y2[6], y2[7]};
                    bf16_t* ob = p.KRb + (size_t)row * 64 + 8 * fq;
                    *(u32x4*)ob = (u32x4){pk2(y1[0], y1[1]), pk2(y1[2], y1[3]), pk2(y1[4], y1[5]), pk2(y1[6], y1[7])};
                    *(u32x4*)(ob + 32) = (u32x4){pk2(y2[0], y2[1]), pk2(y2[2], y2[3]), pk2(y2[4], y2[5]), pk2(y2[6], y2[7])};
                }
            }
    }
};

__device__ __forceinline__ void ckv_pass(const Prm& p, int lane, int wave) {
    const int gw = blockIdx.x * NWAVES + wave, NGW = gridDim.x * NWAVES;
    for (int row = gw; row < MT; row += NGW) {
        const float* sq = p.ssq1 + (size_t)row * 16 + 8; float s = 0.f;
#pragma unroll
        for (int j = 0; j < 8; ++j) s += sq[j];
        const float r = rsqrtf(s * (1.f / KVL) + EPS);
        const u32x4 z = *(const u32x4*)(p.ZCKV + (size_t)row * KVL + 8 * lane);
        const f32x4 g0 = *(const f32x4*)(p.in[11] + 8 * lane), g1 = *(const f32x4*)(p.in[11] + 8 * lane + 4);
        f32x4 o0, o1;
        o0.x = bflo(z.x) * r * g0.x; o0.y = bfhi(z.x) * r * g0.y; o0.z = bflo(z.y) * r * g0.z; o0.w = bfhi(z.y) * r * g0.w;
        o1.x = bflo(z.z) * r * g1.x; o1.y = bfhi(z.z) * r * g1.y; o1.z = bflo(z.w) * r * g1.z; o1.w = bfhi(z.w) * r * g1.w;
        float* of = row < MP ? p.out + O_CKVP + (size_t)row * KVL + 8 * lane : p.out + O_CKVS + (size_t)(row - MP) * KVL + 8 * lane;
        *(f32x4*)of = o0; *(f32x4*)(of + 4) = o1;
        if (row >= MP) *(u32x4*)(p.CKVNs + (size_t)(row - MP) * KVL + 8 * lane) = (u32x4){pk2(o0.x, o0.y), pk2(o0.z, o0.w), pk2(o1.x, o1.y), pk2(o1.z, o1.w)};
    }
}


struct EpiQ {
    static constexpr bool PERM = true, AFTER_DRAIN = false;
    Prm p;
    __device__ __forceinline__ void operator()(const f32x4 (&acc)[2][2][4][2], const pg8::Unit& u, int wr, int wc, int fr, int fq) const {
        const int pn = u.pn; const int ci = 32 * wc + 8 * fq;
        float rqs[2][4];
#pragma unroll
        for (int ai = 0; ai < 2; ++ai)
#pragma unroll
            for (int m = 0; m < 4; ++m) { const int row = u.pm * 256 + ai * 128 + wr * 64 + m * 16 + fr;
                const f32x4 s0 = *(const f32x4*)(p.ssq1 + (size_t)row * 16), s1 = *(const f32x4*)(p.ssq1 + (size_t)row * 16 + 4);
                rqs[ai][m] = rsqrtf(((s0.x + s0.y) + (s0.z + s0.w) + (s1.x + s1.y) + (s1.z + s1.w)) * (1.f / QL) + EPS) * QSCALE; }
#pragma unroll
        for (int ai = 0; ai < 2; ++ai)
#pragma unroll
            for (int m = 0; m < 4; ++m) {
                const int row = u.pm * 256 + ai * 128 + wr * 64 + m * 16 + fr;
                const float rq = rqs[ai][m];
                if (pn < 4) {
#pragma unroll
                    for (int bj = 0; bj < 2; ++bj) { const f32x4 a = acc[ai][bj][m][0] * rq, b = acc[ai][bj][m][1] * rq;
                        *(u32x4*)(p.Q + (size_t)row * 1536 + (2 * pn + bj) * QKH + ci) = (u32x4){pk2(a[0], a[1]), pk2(a[2], a[3]), pk2(b[0], b[1]), pk2(b[2], b[3])}; }
                } else {
                    const int head = (pn - 4) * 4 + wc; const int pos = rowpos(row);
                    const f32x4* tb = (const f32x4*)(p.tab64 + (size_t)pos * 32 + 8 * fq);
                    float y1[8], y2[8];
#pragma unroll
                    for (int n = 0; n < 2; ++n) { const f32x4 t0 = tb[2 * n], t1 = tb[2 * n + 1]; const f32x4 x1 = acc[ai][0][m][n] * rq, x2 = acc[ai][1][m][n] * rq;
                        const float cs[4] = {t0.x, t0.z, t1.x, t1.z}, sn[4] = {t0.y, t0.w, t1.y, t1.w};
#pragma unroll
                        for (int e = 0; e < 4; ++e) { y1[4 * n + e] = x1[e] * cs[e] - x2[e] * sn[e]; y2[4 * n + e] = x2[e] * cs[e] + x1[e] * sn[e]; } }
                    bf16_t* dst = p.Q + (size_t)row * 1536 + head * QKH + NOPE + 8 * fq;
                    *(u32x4*)dst = (u32x4){pk2(y1[0], y1[1]), pk2(y1[2], y1[3]), pk2(y1[4], y1[5]), pk2(y1[6], y1[7])};
                    *(u32x4*)(dst + 32) = (u32x4){pk2(y2[0], y2[1]), pk2(y2[2], y2[3]), pk2(y2[4], y2[5]), pk2(y2[6], y2[7])};
                }
            }
    }
};
__device__ __forceinline__ float ckv_rscale(const float* ssq1, int row) {
    const f32x4 s0 = *(const f32x4*)(ssq1 + (size_t)row * 16 + 8), s1 = *(const f32x4*)(ssq1 + (size_t)row * 16 + 12);
    return rsqrtf(((s0.x + s0.y) + (s0.z + s0.w) + (s1.x + s1.y) + (s1.z + s1.w)) * (1.f / KVL) + EPS);
}
struct EpiKN {
    static constexpr bool PERM = true, AFTER_DRAIN = false;
    Prm p;
    __device__ __forceinline__ void operator()(const f32x4 (&acc)[2][2][4][2], const pg8::Unit& u, int wr, int wc, int fr, int fq) const {
        const int ci = u.pn * 256 + 32 * wc + 8 * fq;
        float rr[2][4];
#pragma unroll
        for (int ai = 0; ai < 2; ++ai)
#pragma unroll
            for (int m = 0; m < 4; ++m) rr[ai][m] = ckv_rscale(p.ssq1, u.pm * 256 + ai * 128 + wr * 64 + m * 16 + fr);
#pragma unroll
        for (int ai = 0; ai < 2; ++ai)
#pragma unroll
            for (int m = 0; m < 4; ++m) {
                const int row = u.pm * 256 + ai * 128 + wr * 64 + m * 16 + fr; const float r = rr[ai][m];
#pragma unroll
                for (int bj = 0; bj < 2; ++bj) { const f32x4 a = acc[ai][bj][m][0] * r, b = acc[ai][bj][m][1] * r;
                    *(u32x4*)(p.KN + (size_t)row * 1024 + 128 * bj + ci) = (u32x4){pk2(a[0], a[1]), pk2(a[2], a[3]), pk2(b[0], b[1]), pk2(b[2], b[3])}; }
            }
    }
};
struct EpiVT {
    static constexpr bool PERM = true, AFTER_DRAIN = false;
    Prm p;
    __device__ __forceinline__ void operator()(const f32x4 (&acc)[2][2][4][2], const pg8::Unit& u, int wr, int wc, int fr, int fq) const {
        const int ci = u.pn * 256 + 32 * wc + 8 * fq;
#pragma unroll
        for (int bj = 0; bj < 2; ++bj) {
            float r[8];
#pragma unroll
            for (int e = 0; e < 8; ++e) r[e] = ckv_rscale(p.ssq1, 128 * bj + ci + e);
#pragma unroll
            for (int ai = 0; ai < 2; ++ai)
#pragma unroll
                for (int m = 0; m < 4; ++m) {
                    const int row = u.pm * 256 + ai * 128 + wr * 64 + m * 16 + fr;
                    const f32x4 a = acc[ai][bj][m][0], b = acc[ai][bj][m][1];
                    *(u32x4*)(p.VTp + (size_t)row * MP + 128 * bj + ci) = (u32x4){pk2(a[0] * r[0], a[1] * r[1]), pk2(a[2] * r[2], a[3] * r[3]), pk2(b[0] * r[4], b[1] * r[5]), pk2(b[2] * r[6], b[3] * r[7])};
                }
        }
    }
};
struct EpiPP {
    static constexpr bool PERM = true, AFTER_DRAIN = false;
    bf16_t* O; int ldc;
    __device__ __forceinline__ void operator()(const f32x4 (&acc)[2][2][4][2], const pg8::Unit& u, int wr, int wc, int fr, int fq) const {
        const int ci = u.pn * 256 + 32 * wc + 8 * fq;
#pragma unroll
        for (int ai = 0; ai < 2; ++ai)
#pragma unroll
            for (int m = 0; m < 4; ++m) {
                const int row = u.pm * 256 + ai * 128 + wr * 64 + m * 16 + fr;
#pragma unroll
                for (int bj = 0; bj < 2; ++bj) { const f32x4 a = acc[ai][bj][m][0], b = acc[ai][bj][m][1];
                    *(u32x4*)(O + (size_t)row * ldc + 128 * bj + ci) = (u32x4){pk2(a[0], a[1]), pk2(a[2], a[3]), pk2(b[0], b[1]), pk2(b[2], b[3])}; }
            }
    }
};

__device__ __forceinline__ bf16x8 ld2x8(const bf16_t* p0) {
    const u32x2 a = *(const u32x2*)p0, b = *(const u32x2*)(p0 + 16);
    return __builtin_bit_cast(bf16x8, (u32x4){a.x, a.y, b.x, b.y});
}
template <int L> __device__ __forceinline__ void ret_stepA(const Prm& p, LAS unsigned char* lds, int cid, int h, int lane, int wave) {
    asm volatile("" : "+v"(lane));
    constexpr int NLB = L / 16, NPART = 8 / NLB, DVP = 256 / NPART, NDB = DVP / 16, NKS = L / 32;
    const int fr = lane & 15, fq = lane >> 4;
    const int row0 = (L == 64) ? cid * 64 : MP + (cid - 128) * 32;
    const int lb = wave % NLB, part = wave / NLB;
    const float lg = lg2gamma(h);
    bf16x8 qf[8];
    { const bf16_t* qp = p.RQ + (size_t)(row0 + 16 * lb + fr) * RW + h * 256 + 8 * fq;
#pragma unroll
      for (int ks = 0; ks < 8; ++ks) qf[ks] = *(const bf16x8*)(qp + 32 * ks); }
#define SB2() __builtin_amdgcn_sched_barrier(0)
    f32x4 sc[NLB];
#pragma unroll
    for (int mp = 0; mp < NLB; mp += 2) {
        bf16x8 kf[2][8];
#pragma unroll
        for (int d = 0; d < 2; ++d) { const int mb = mp + d; const int mbc = mb <= lb ? mb : lb;
            const bf16_t* kp = p.RK + (size_t)(row0 + 16 * mbc + fr) * RW + h * 256 + 8 * fq;
#pragma unroll
            for (int ks = 0; ks < 8; ++ks) kf[d][ks] = *(const bf16x8*)(kp + 32 * ks); }
        SB2();
#pragma unroll
        for (int d = 0; d < 2; ++d) { const int mb = mp + d; f32x4 a = {0.f, 0.f, 0.f, 0.f};
#pragma unroll
            for (int ks = 0; ks < 8; ++ks) a = mfma16(kf[d][ks], qf[ks], a);
            const int l = 16 * lb + fr;
#pragma unroll
            for (int rg = 0; rg < 4; ++rg) { const int mm = 16 * mb + 4 * fq + rg; sc[mb][rg] = (mb <= lb && l >= mm) ? a[rg] * __builtin_amdgcn_exp2f((float)(l - mm) * lg) : 0.f; } }
        SB2();
    }
    bf16x8 pf[NKS];
#pragma unroll
    for (int j = 0; j < NKS; ++j) pf[j] = pack8(sc[2 * j], sc[2 * j + 1]);
    { bf16x8 vf[NDB][NKS];
#pragma unroll
      for (int db = 0; db < NDB; ++db) { const bf16_t* vp = p.RVt + (size_t)(h * 256 + part * DVP + 16 * db + fr) * MT + row0 + 4 * fq;
#pragma unroll
          for (int j = 0; j < NKS; ++j) vf[db][j] = ld2x8(vp + 32 * j); }
      SB2();
#pragma unroll
      for (int db = 0; db < NDB; ++db) { f32x4 o = {0.f, 0.f, 0.f, 0.f};
#pragma unroll
          for (int j = 0; j < NKS; ++j) o = mfma16(vf[db][j], pf[j], o);
          *(f32x4*)(p.OINTRA + (size_t)(row0 + 16 * lb + fr) * RW + h * 256 + part * DVP + 16 * db + 4 * fq) = o; }
      SB2(); }
    { const bf16_t* xsrc = (L == 64) ? p.RVt : p.RKt; const bf16_t* ysrc = (L == 64) ? p.RKt : p.RVt;
      const float g32 = __builtin_amdgcn_exp2f(32.f * lg);
      LAS float* wt = (LAS float*)(lds + wave * 8704);
      bf16x8 xf[2][NKS];
#pragma unroll
      for (int a = 0; a < 2; ++a)
#pragma unroll
          for (int ks = 0; ks < NKS; ++ks) xf[a][ks] = *(const bf16x8*)(xsrc + (size_t)(h * 256 + 32 * wave + 16 * a + fr) * MT + row0 + 32 * ks + 8 * fq);
      float* dstbase = p.out + O_RETS + ((size_t)((L == 64 ? 0 : cid - 128) * 4 + h) * 256 + 32 * wave) * 256;
      bf16_t* kvbase = (bf16_t*)p.KVp + ((size_t)((L == 64 ? cid : 0) * 4 + h) * 256 + 32 * wave) * 256;
      const float* s0base = p.in[4] + ((size_t)((cid - 128) * 4 + h) * 256 + 32 * wave) * 256;
#pragma unroll
      for (int kg = 0; kg < 4; ++kg) {
          bf16x8 yf[4][NKS]; f32x4 s0v[8];
#pragma unroll
          for (int k4 = 0; k4 < 4; ++k4) { const bf16_t* kp = ysrc + (size_t)(h * 256 + 16 * (4 * kg + k4) + fr) * MT + row0 + 8 * fq;
#pragma unroll
              for (int ks = 0; ks < NKS; ++ks) yf[k4][ks] = *(const bf16x8*)(kp + 32 * ks); }
          if (L == 32) {
#pragma unroll
              for (int q = 0; q < 8; ++q) s0v[q] = *(const f32x4*)(s0base + (size_t)(4 * q + (lane >> 4)) * 256 + 64 * kg + 4 * (lane & 15));
          }
          SB2();
#pragma unroll
          for (int k4 = 0; k4 < 4; ++k4)
#pragma unroll
              for (int a = 0; a < 2; ++a) { f32x4 o = {0.f, 0.f, 0.f, 0.f};
#pragma unroll
                  for (int ks = 0; ks < NKS; ++ks) o = mfma16(xf[a][ks], yf[k4][ks], o);
#pragma unroll
                  for (int rg = 0; rg < 4; ++rg) wt[(16 * a + 4 * fq + rg) * 68 + 16 * k4 + fr] = o[rg]; }
          LDS_WAIT();
#pragma unroll
          for (int q = 0; q < 8; ++q) { const int r = 4 * q + (lane >> 4); f32x4 v = *(const LAS f32x4*)(wt + r * 68 + 4 * (lane & 15));
              if (L == 32) { v = s0v[q] * g32 + v; *(f32x4*)(dstbase + (size_t)r * 256 + 64 * kg + 4 * (lane & 15)) = v; }
              else *(u32x2*)(kvbase + (size_t)r * 256 + 64 * kg + 4 * (lane & 15)) = (u32x2){pk2(v[0], v[1]), pk2(v[2], v[3])}; }
          LDS_WAIT();
          SB2();
      } }
#undef SB2
}

template <int M2 = 7> __device__ __forceinline__ void phase2(const Prm& p, LAS unsigned char* lds, int tid, int lane, int wave) {
    const int G = (int)gridDim.x, c = (int)blockIdx.x;
#ifndef SKIP_G1
    if (M2 & 1) { pg8::Gemm g{p.ZCQ, p.WuqT, MT, 1536, QL}; pg8::StaticOrder S; S.init(MT, 1536, G, c); S.wv = wave; EpiQ E{p}; pg8::gemm_phase<EpiQ, pg8::StaticOrder, true, true>(lds, g, S, E); }
#endif
#ifndef SKIP_G2
    if (M2 & 1) { pg8::Gemm g{p.ZCKV, p.WukT, MP, 1024, KVL}; pg8::StaticOrder S; S.init(MP, 1024, G, (c + 40) & 255); S.wv = wave; EpiKN E{p};        pg8::gemm_phase<EpiKN, pg8::StaticOrder, true, true>(lds, g, S, E); }
#endif
#ifndef SKIP_G3
    if (M2 & 1) { pg8::Gemm g{p.WuvTg, p.ZCKV, 1024, MP, KVL}; pg8::StaticOrder S; S.init(1024, MP, G, (c - 88) & 255); S.wv = wave; EpiVT E{p}; pg8::gemm_phase<EpiVT, pg8::StaticOrder, true, true>(lds, g, S, E); }
#endif
    { int t2 = lane_id(); asm volatile("" : "+v"(t2)); lane = t2; }
    if (M2 & 2) ckv_pass(p, lane, wave);
#ifndef SKIP_RA
    if (M2 & 28) for (int u = c; u < 640; u += G) {
        if ((M2 & 8) && !(M2 & 4) && u >= 512) continue;
        if ((M2 & 16) && !(M2 & 4) && u < 512) continue;
        const int cid = u >> 2, h = u & 3;
        if (cid < 128) ret_stepA<64>(p, lds, cid, h, lane, wave); else ret_stepA<32>(p, lds, cid, h, lane, wave);
    }
#endif
}
constexpr int P3_MAXU = 5;
__device__ const unsigned short p3_sched[256][P3_MAXU] = {
{0,65535,65535,65535,65535},
{16,65535,65535,65535,65535},
{32,65535,65535,65535,65535},
{48,65535,65535,65535,65535},
{64,65535,65535,65535,65535},
{80,65535,65535,65535,65535},
{96,65535,65535,65535,65535},
{112,65535,65535,65535,65535},
{1,65535,65535,65535,65535},
{17,65535,65535,65535,65535},
{33,65535,65535,65535,65535},
{49,65535,65535,65535,65535},
{65,65535,65535,65535,65535},
{81,65535,65535,65535,65535},
{97,65535,65535,65535,65535},
{113,65535,65535,65535,65535},
{2,65535,65535,65535,65535},
{18,65535,65535,65535,65535},
{34,65535,65535,65535,65535},
{50,65535,65535,65535,65535},
{66,65535,65535,65535,65535},
{82,65535,65535,65535,65535},
{98,65535,65535,65535,65535},
{114,65535,65535,65535,65535},
{3,65535,65535,65535,65535},
{19,65535,65535,65535,65535},
{35,65535,65535,65535,65535},
{51,65535,65535,65535,65535},
{67,65535,65535,65535,65535},
{83,65535,65535,65535,65535},
{99,65535,65535,65535,65535},
{115,65535,65535,65535,65535},
{4,65535,65535,65535,65535},
{20,65535,65535,65535,65535},
{36,65535,65535,65535,65535},
{52,65535,65535,65535,65535},
{68,65535,65535,65535,65535},
{84,65535,65535,65535,65535},
{100,65535,65535,65535,65535},
{116,65535,65535,65535,65535},
{5,65535,65535,65535,65535},
{21,65535,65535,65535,65535},
{37,65535,65535,65535,65535},
{53,65535,65535,65535,65535},
{69,65535,65535,65535,65535},
{85,65535,65535,65535,65535},
{101,65535,65535,65535,65535},
{117,65535,65535,65535,65535},
{6,65535,65535,65535,65535},
{22,65535,65535,65535,65535},
{38,65535,65535,65535,65535},
{54,65535,65535,65535,65535},
{70,65535,65535,65535,65535},
{86,65535,65535,65535,65535},
{102,65535,65535,65535,65535},
{118,65535,65535,65535,65535},
{7,65535,65535,65535,65535},
{23,65535,65535,65535,65535},
{39,65535,65535,65535,65535},
{55,65535,65535,65535,65535},
{71,65535,65535,65535,65535},
{87,65535,65535,65535,65535},
{103,65535,65535,65535,65535},
{119,65535,65535,65535,65535},
{8,65535,65535,65535,65535},
{24,65535,65535,65535,65535},
{40,65535,65535,65535,65535},
{56,65535,65535,65535,65535},
{72,65535,65535,65535,65535},
{88,65535,65535,65535,65535},
{104,65535,65535,65535,65535},
{120,65535,65535,65535,65535},
{9,65535,65535,65535,65535},
{25,65535,65535,65535,65535},
{41,65535,65535,65535,65535},
{57,65535,65535,65535,65535},
{73,65535,65535,65535,65535},
{89,65535,65535,65535,65535},
{105,65535,65535,65535,65535},
{121,65535,65535,65535,65535},
{10,65535,65535,65535,65535},
{26,65535,65535,65535,65535},
{42,65535,65535,65535,65535},
{58,65535,65535,65535,65535},
{74,65535,65535,65535,65535},
{90,65535,65535,65535,65535},
{106,65535,65535,65535,65535},
{122,65535,65535,65535,65535},
{11,65535,65535,65535,65535},
{27,65535,65535,65535,65535},
{43,65535,65535,65535,65535},
{59,65535,65535,65535,65535},
{75,65535,65535,65535,65535},
{91,65535,65535,65535,65535},
{107,65535,65535,65535,65535},
{123,65535,65535,65535,65535},
{12,65535,65535,65535,65535},
{28,65535,65535,65535,65535},
{44,65535,65535,65535,65535},
{60,65535,65535,65535,65535},
{76,65535,65535,65535,65535},
{92,65535,65535,65535,65535},
{108,65535,65535,65535,65535},
{124,65535,65535,65535,65535},
{13,65535,65535,65535,65535},
{29,65535,65535,65535,65535},
{45,65535,65535,65535,65535},
{61,65535,65535,65535,65535},
{77,65535,65535,65535,65535},
{93,65535,65535,65535,65535},
{109,65535,65535,65535,65535},
{125,65535,65535,65535,65535},
{14,65535,65535,65535,65535},
{30,65535,65535,65535,65535},
{46,65535,65535,65535,65535},
{62,65535,65535,65535,65535},
{78,65535,65535,65535,65535},
{94,65535,65535,65535,65535},
{110,65535,65535,65535,65535},
{126,65535,65535,65535,65535},
{15,65535,65535,65535,65535},
{31,65535,65535,65535,65535},
{47,65535,65535,65535,65535},
{63,65535,65535,65535,65535},
{79,65535,65535,65535,65535},
{95,65535,65535,65535,65535},
{111,65535,65535,65535,65535},
{127,65535,65535,65535,65535},
{624,384,368,128,65535},
{626,386,370,130,65535},
{628,388,372,132,65535},
{630,390,374,134,65535},
{632,392,376,136,65535},
{634,394,378,138,65535},
{636,396,380,140,65535},
{638,398,382,142,65535},
{625,385,369,129,65535},
{627,387,371,131,65535},
{629,389,373,133,65535},
{631,391,375,135,65535},
{633,393,377,137,65535},
{635,395,379,139,65535},
{637,397,381,141,65535},
{639,399,383,143,65535},
{608,400,352,144,65535},
{610,402,354,146,65535},
{612,404,356,148,65535},
{614,406,358,150,65535},
{616,408,360,152,65535},
{618,410,362,154,65535},
{620,412,364,156,65535},
{622,414,366,158,65535},
{609,401,353,145,65535},
{611,403,355,147,65535},
{613,405,357,149,65535},
{615,407,359,151,65535},
{617,409,361,153,65535},
{619,411,363,155,65535},
{621,413,365,157,65535},
{623,415,367,159,65535},
{592,416,336,160,65535},
{594,418,338,162,65535},
{596,420,340,164,65535},
{598,422,342,166,65535},
{600,424,344,168,65535},
{602,426,346,170,65535},
{604,428,348,172,65535},
{606,430,350,174,65535},
{593,417,337,161,65535},
{595,419,339,163,65535},
{597,421,341,165,65535},
{599,423,343,167,65535},
{601,425,345,169,65535},
{603,427,347,171,65535},
{605,429,349,173,65535},
{607,431,351,175,65535},
{576,432,320,176,65535},
{578,434,322,178,65535},
{580,436,324,180,65535},
{582,438,326,182,65535},
{584,440,328,184,65535},
{586,442,330,186,65535},
{588,444,332,188,65535},
{590,446,334,190,65535},
{577,433,321,177,65535},
{579,435,323,179,65535},
{581,437,325,181,65535},
{583,439,327,183,65535},
{585,441,329,185,65535},
{587,443,331,187,65535},
{589,445,333,189,65535},
{591,447,335,191,65535},
{560,448,304,192,65535},
{562,450,306,194,65535},
{564,452,308,196,65535},
{566,454,310,198,65535},
{568,456,312,200,65535},
{570,458,314,202,65535},
{572,460,316,204,65535},
{574,462,318,206,65535},
{561,449,305,193,65535},
{563,451,307,195,65535},
{565,453,309,197,65535},
{567,455,311,199,65535},
{569,457,313,201,65535},
{571,459,315,203,65535},
{573,461,317,205,65535},
{575,463,319,207,65535},
{544,464,288,208,65535},
{546,466,290,210,65535},
{548,468,292,212,65535},
{550,470,294,214,65535},
{552,472,296,216,65535},
{554,474,298,218,65535},
{556,476,300,220,65535},
{558,478,302,222,65535},
{545,465,289,209,65535},
{547,467,291,211,65535},
{549,469,293,213,65535},
{551,471,295,215,65535},
{553,473,297,217,65535},
{555,475,299,219,65535},
{557,477,301,221,65535},
{559,479,303,223,65535},
{528,480,272,224,65535},
{530,482,274,226,65535},
{532,484,276,228,65535},
{534,486,278,230,65535},
{536,488,280,232,65535},
{538,490,282,234,65535},
{540,492,284,236,65535},
{542,494,286,238,65535},
{529,481,273,225,65535},
{531,483,275,227,65535},
{533,485,277,229,65535},
{535,487,279,231,65535},
{537,489,281,233,65535},
{539,491,283,235,65535},
{541,493,285,237,65535},
{543,495,287,239,65535},
{512,496,256,240,65535},
{514,498,258,242,65535},
{516,500,260,244,65535},
{518,502,262,246,65535},
{520,504,264,248,65535},
{522,506,266,250,65535},
{524,508,268,252,65535},
{526,510,270,254,65535},
{513,497,257,241,65535},
{515,499,259,243,65535},
{517,501,261,245,65535},
{519,503,263,247,65535},
{521,505,265,249,65535},
{523,507,267,251,65535},
{525,509,269,253,65535},
{527,511,271,255,65535}
};

__device__ __forceinline__ void ret_scan(const Prm& p, int tid) {
    const long gt = (long)blockIdx.x * NTHR + tid, NGT = (long)gridDim.x * NTHR;
    for (long e = gt; e < 131072; e += NGT) {
        const int h = (int)(e >> 15), x = (int)(e & 32767) * 2;
        const float g64 = __builtin_amdgcn_exp2f(64.f * lg2gamma(h));
        float S0 = 0.f, S1 = 0.f;
        const unsigned* kv = (const unsigned*)((const bf16_t*)p.KVp + (size_t)h * 65536 + x); unsigned* sp = (unsigned*)(p.SPREV + (size_t)h * 65536 + x);
        for (int c0 = 0; c0 < 128; c0 += 32) {
            unsigned v[32];
#pragma unroll
            for (int j = 0; j < 32; ++j) v[j] = kv[(size_t)(c0 + j) * 131072];
#pragma unroll
            for (int j = 0; j < 32; ++j) { sp[(size_t)(c0 + j) * 131072] = pk2(S0, S1); S0 = g64 * S0 + bflo(v[j]); S1 = g64 * S1 + bfhi(v[j]); }
        }
        const int dv = x >> 8, dk = x & 255;
        p.out[O_RETP + (size_t)h * 65536 + dk * 256 + dv] = S0; p.out[O_RETP + (size_t)h * 65536 + (dk + 1) * 256 + dv] = S1;
    }
}

#define SB() __builtin_amdgcn_sched_barrier(0)
constexpr int AP_LDK = 208, AP_LDV = 80, AP_KBYTES = 64 * AP_LDK * 2, AP_VBYTES = 128 * AP_LDV * 2;
__device__ __forceinline__ void attn_prompt_unit(const Prm& p, LAS unsigned char* lds, int qb, int h, int tid, int lane, int wave) {
    asm volatile("" : "+v"(tid), "+v"(lane));
    const int fr = lane & 15, fq = lane >> 4;
    LAS bf16_t* Ks = (LAS bf16_t*)lds; LAS bf16_t* Vs = (LAS bf16_t*)(lds + AP_KBYTES);
    const int qrow = 128 * qb + 16 * wave + fr; const int qchunk = 2 * qb + (wave >> 2);
    bf16x8 qf[6];
#pragma unroll
    for (int ks = 0; ks < 6; ++ks) qf[ks] = *(const bf16x8*)(p.Q + (size_t)qrow * 1536 + h * QKH + 32 * ks + 8 * fq);
    float mrun = -1e30f, lrun = 0.f; f32x4 o[8];
#pragma unroll
    for (int db = 0; db < 8; ++db) o[db] = (f32x4){0.f, 0.f, 0.f, 0.f};
    const int ntile = 2 * qb + 2;
    u32x4 kreg[3], vreg[2];
    const int sr = tid >> 3, sc = tid & 7;
    const bf16_t* kn_src = p.KN + (size_t)sr * 1024 + h * 128 + sc * 8; const bf16_t* kr_src = p.KRb + (size_t)sr * 64 + sc * 8;
    const bf16_t* vt_src = p.VTp + (size_t)(h * 128 + sr) * MP + sc * 8;
    auto issue = [&](int kt) {
        const size_t key0 = (size_t)kt * 64;
        kreg[0] = *(const u32x4*)(kn_src + key0 * 1024); kreg[1] = *(const u32x4*)(kn_src + key0 * 1024 + 64); kreg[2] = *(const u32x4*)(kr_src + key0 * 64);
        vreg[0] = *(const u32x4*)(vt_src + key0); vreg[1] = *(const u32x4*)(vt_src + (size_t)64 * MP + key0);
    };
    constexpr int AP_STAGE = AP_KBYTES + AP_VBYTES;
#define AP_WRITE(buf) do { LAS bf16_t* kd = (LAS bf16_t*)(lds + (buf) * AP_STAGE) + sr * AP_LDK + sc * 8; *(LAS u32x4*)kd = kreg[0]; *(LAS u32x4*)(kd + 64) = kreg[1]; *(LAS u32x4*)(kd + 128) = kreg[2]; \
        LAS bf16_t* vd = (LAS bf16_t*)(lds + (buf) * AP_STAGE + AP_KBYTES) + sr * AP_LDV + 32 * (sc >> 2) + 16 * (sc & 1) + 4 * ((sc >> 1) & 1);        \
        *(LAS u32x2*)vd = (u32x2){vreg[0].x, vreg[0].y}; *(LAS u32x2*)(vd + 8) = (u32x2){vreg[0].z, vreg[0].w}; \
        *(LAS u32x2*)(vd + 64 * AP_LDV) = (u32x2){vreg[1].x, vreg[1].y}; *(LAS u32x2*)(vd + 64 * AP_LDV + 8) = (u32x2){vreg[1].z, vreg[1].w}; } while (0)
    issue(0);
    AP_WRITE(0);
    __syncthreads();
    for (int kt = 0; kt < ntile; ++kt) {
        Ks = (LAS bf16_t*)(lds + (kt & 1) * AP_STAGE); Vs = (LAS bf16_t*)(lds + (kt & 1) * AP_STAGE + AP_KBYTES);
        if (kt + 1 < ntile) issue(kt + 1);
        if (kt <= qchunk) {
            f32x4 s[4]; bf16x8 kf[2][6];
#define AP_LDK(buf, kb) do { _Pragma("unroll") for (int ks = 0; ks < 6; ++ks) kf[buf][ks] = *(const LAS bf16x8*)(Ks + (16 * (kb) + fr) * AP_LDK + 32 * ks + 8 * fq); } while (0)
            AP_LDK(0, 0);
            __builtin_amdgcn_s_setprio(1);
#pragma unroll
            for (int kb = 0; kb < 4; ++kb) { s[kb] = (f32x4){0.f, 0.f, 0.f, 0.f};
                if (kb < 3) AP_LDK((kb + 1) & 1, kb + 1);
                SB();
#pragma unroll
                for (int ks = 0; ks < 6; ++ks) s[kb] = mfma16(kf[kb & 1][ks], qf[ks], s[kb]);
                SB(); }
            bf16x8 vf[2][4];
#define AP_LDV(buf, g) do { _Pragma("unroll") for (int d2 = 0; d2 < 2; ++d2) { const LAS bf16_t* vp = Vs + (16 * (2 * (g) + d2) + fr) * AP_LDV + 8 * fq; \
                vf[buf][2 * d2] = *(const LAS bf16x8*)vp; vf[buf][2 * d2 + 1] = *(const LAS bf16x8*)(vp + 32); } } while (0)
            AP_LDV(0, 0);
            __builtin_amdgcn_s_setprio(0);
            SB();
            float mx = fmaxf(fmaxf(fmaxf(s[0][0], s[0][1]), fmaxf(s[0][2], s[0][3])), fmaxf(fmaxf(s[1][0], s[1][1]), fmaxf(s[1][2], s[1][3])));
            mx = fmaxf(mx, fmaxf(fmaxf(fmaxf(s[2][0], s[2][1]), fmaxf(s[2][2], s[2][3])), fmaxf(fmaxf(s[3][0], s[3][1]), fmaxf(s[3][2], s[3][3]))));
            mx = fmaxf(mx, __shfl_xor(mx, 16)); mx = fmaxf(mx, __shfl_xor(mx, 32));
            const float mnew = fmaxf(mrun, mx), alpha = __builtin_amdgcn_exp2f(mrun - mnew); mrun = mnew;
            float ps = 0.f;
#pragma unroll
            for (int kb = 0; kb < 4; ++kb)
#pragma unroll
                for (int rg = 0; rg < 4; ++rg) { s[kb][rg] = __builtin_amdgcn_exp2f(s[kb][rg] - mnew); ps += s[kb][rg]; }
            lrun = lrun * alpha + ps;
            const bf16x8 pf0 = pack8(s[0], s[1]), pf1 = pack8(s[2], s[3]);
            SB();
            __builtin_amdgcn_s_setprio(1);
#pragma unroll
            for (int g = 0; g < 4; ++g) {
                if (g < 3) AP_LDV((g + 1) & 1, g + 1);
                SB();
#pragma unroll
                for (int d2 = 0; d2 < 2; ++d2) { const int db = 2 * g + d2;
                    o[db] = o[db] * alpha;
                    o[db] = mfma16(vf[g & 1][2 * d2], pf0, o[db]);
                    o[db] = mfma16(vf[g & 1][2 * d2 + 1], pf1, o[db]); }
                SB(); }
            __builtin_amdgcn_s_setprio(0);
#undef AP_LDK
#undef AP_LDV
        }
        if (kt + 1 < ntile) AP_WRITE((kt + 1) & 1);
        __syncthreads();
    }
#undef AP_WRITE
    lrun += __shfl_xor(lrun, 16); lrun += __shfl_xor(lrun, 32);
    const float inv = 1.f / lrun;
#pragma unroll
    for (int db = 0; db < 8; ++db) { const f32x4 v = o[db] * inv;
        *(u32x2*)(p.ACat + (size_t)qrow * DM + MLAW + h * VH + 16 * db + 4 * fq) = (u32x2){pk2(v[0], v[1]), pk2(v[2], v[3])}; }
}

typedef float f32x16 __attribute__((ext_vector_type(16)));
__device__ __forceinline__ f32x16 mfma32(bf16x8 a, bf16x8 b, f32x16 c) { return __builtin_amdgcn_mfma_f32_32x32x16_bf16(a, b, c, 0, 0, 0); }
constexpr int A2_LDK = 200, A2_LDV = 72, A2_KB = 64 * A2_LDK * 2, A2_VB = 128 * A2_LDV * 2, A2_STAGE = A2_KB + A2_VB, A2_LDO = 136;
__device__ __forceinline__ void attn_prompt_unit2(const Prm& p, LAS unsigned char* lds, int qb, int h, int kh, int tid, int lane, int wave) {
    asm volatile("" : "+v"(tid), "+v"(lane));
    const int r = lane & 31, hh = lane >> 5;
    const int qrow = 256 * qb + 32 * wave + r; const int chunk = 4 * qb + (wave >> 1);
    bf16x8 qf[12];
#pragma unroll
    for (int ks = 0; ks < 12; ++ks) qf[ks] = *(const bf16x8*)(p.Q + (size_t)qrow * 1536 + h * QKH + 16 * ks + 8 * hh);
    float mrun = -1e30f, lrun = 0.f; f32x16 o[4];
#pragma unroll
    for (int db = 0; db < 4; ++db)
#pragma unroll
        for (int e = 0; e < 16; ++e) o[db][e] = 0.f;
    const int nsub = 2 * qb + 2;
    u32x4 kreg[3], vreg[2];
    const int sr = tid >> 3, sc = tid & 7;
    const bf16_t* kn_src = p.KN + (size_t)sr * 1024 + h * 128 + sc * 8; const bf16_t* kr_src = p.KRb + (size_t)sr * 64 + sc * 8;
    const bf16_t* vt_src = p.VTp + (size_t)(h * 128 + sr) * MP + sc * 8;
    auto issue = [&](int i) {
        const size_t key0 = (size_t)(2 * i + kh) * 64;
        kreg[0] = *(const u32x4*)(kn_src + key0 * 1024); kreg[1] = *(const u32x4*)(kn_src + key0 * 1024 + 64); kreg[2] = *(const u32x4*)(kr_src + key0 * 64);
        vreg[0] = *(const u32x4*)(vt_src + key0); vreg[1] = *(const u32x4*)(vt_src + (size_t)64 * MP + key0);
    };
#define A2_WRITE(buf) do { LAS bf16_t* kd = (LAS bf16_t*)(lds + (buf) * A2_STAGE) + sr * A2_LDK + sc * 8; *(LAS u32x4*)kd = kreg[0]; *(LAS u32x4*)(kd + 64) = kreg[1]; *(LAS u32x4*)(kd + 128) = kreg[2]; \
        LAS bf16_t* vd = (LAS bf16_t*)(lds + (buf) * A2_STAGE + A2_KB) + sr * A2_LDV + 16 * (sc >> 1) + 4 * (sc & 1); \
        *(LAS u32x2*)vd = (u32x2){vreg[0].x, vreg[0].y}; *(LAS u32x2*)(vd + 8) = (u32x2){vreg[0].z, vreg[0].w}; \
        *(LAS u32x2*)(vd + 64 * A2_LDV) = (u32x2){vreg[1].x, vreg[1].y}; *(LAS u32x2*)(vd + 64 * A2_LDV + 8) = (u32x2){vreg[1].z, vreg[1].w}; } while (0)
    issue(0);
    A2_WRITE(0);
    __syncthreads();
    for (int i = 0; i < nsub; ++i) {
        const LAS bf16_t* Ks = (const LAS bf16_t*)(lds + (i & 1) * A2_STAGE); const LAS bf16_t* Vs = (const LAS bf16_t*)(lds + (i & 1) * A2_STAGE + A2_KB);
        if (i + 1 < nsub) issue(i + 1);
        if (2 * i + kh <= chunk) {
            const LAS bf16_t* vp = Vs + r * A2_LDV + 8 * hh;
#pragma unroll
            for (int blk = 0; blk < 2; ++blk) {
                f32x16 s;
                { const LAS bf16_t* kp = Ks + (32 * blk + r) * A2_LDK + 8 * hh; bf16x8 kf[2];
#define A2_LDK1(ks) do { if ((ks) < 12) kf[(ks) & 1] = *(const LAS bf16x8*)(kp + 16 * (ks)); } while (0)
                  A2_LDK1(0); A2_LDK1(1);
#pragma unroll
                  for (int e = 0; e < 16; ++e) s[e] = 0.f;
                  __builtin_amdgcn_s_setprio(1);
#pragma unroll
                  for (int ks = 0; ks < 12; ++ks) { SB(); s = mfma32(kf[ks & 1], qf[ks], s); A2_LDK1(ks + 2); SB(); }
                  __builtin_amdgcn_s_setprio(0);
#undef A2_LDK1
                }
                bf16x8 vf[4];
#define A2_LDV1(n) do { if ((n) < 8) vf[(n) & 3] = *(const LAS bf16x8*)(vp + 32 * ((n) >> 1) * A2_LDV + 32 * blk + 16 * ((n) & 1)); } while (0)
                A2_LDV1(0); A2_LDV1(1); A2_LDV1(2); A2_LDV1(3);
                float mx = s[0];
#pragma unroll
                for (int e = 1; e < 16; ++e) mx = fmaxf(mx, s[e]);
                mx = fmaxf(mx, __shfl_xor(mx, 32));
                if (__builtin_amdgcn_ballot_w64(mx > mrun + 8.f) != 0ull) {
                    const float mnew = fmaxf(mrun, mx), alpha = __builtin_amdgcn_exp2f(mrun - mnew); mrun = mnew; lrun *= alpha;
#pragma unroll
                    for (int db = 0; db < 4; ++db) o[db] = o[db] * alpha;
                }
                float ps = 0.f;
#pragma unroll
                for (int e = 0; e < 16; ++e) { s[e] = __builtin_amdgcn_exp2f(s[e] - mrun); ps += s[e]; }
                lrun += ps;
                const bf16x8 pf0 = pack8((f32x4){s[0], s[1], s[2], s[3]}, (f32x4){s[4], s[5], s[6], s[7]}), pf1 = pack8((f32x4){s[8], s[9], s[10], s[11]}, (f32x4){s[12], s[13], s[14], s[15]});
                __builtin_amdgcn_s_setprio(1);
#pragma unroll
                for (int n = 0; n < 8; ++n) { SB(); o[n >> 1] = mfma32(vf[n & 3], (n & 1) ? pf1 : pf0, o[n >> 1]); A2_LDV1(n + 4); SB(); }
                __builtin_amdgcn_s_setprio(0);
#undef A2_LDV1
            }
        }
        if (i + 1 < nsub) A2_WRITE((i + 1) & 1);
        __syncthreads();
    }
#undef A2_WRITE
    lrun += __shfl_xor(lrun, 32);
    const float inv = lrun > 0.f ? 1.f / lrun : 0.f;
    LAS bf16_t* ot = (LAS bf16_t*)(lds + wave * (32 * A2_LDO * 2));
#pragma unroll
    for (int db = 0; db < 4; ++db)
#pragma unroll
        for (int g4 = 0; g4 < 4; ++g4) *(LAS u32x2*)(ot + r * A2_LDO + 32 * db + 8 * g4 + 4 * hh) = (u32x2){pk2(o[db][4 * g4] * inv, o[db][4 * g4 + 1] * inv), pk2(o[db][4 * g4 + 2] * inv, o[db][4 * g4 + 3] * inv)};
    LDS_WAIT();
    bf16_t* po = p.PARTO + ((size_t)kh * MP + 256 * qb + 32 * wave) * MLAW + h * VH;
#pragma unroll
    for (int it = 0; it < 8; ++it) { const int rr = 4 * it + (lane >> 4), cc = lane & 15;
        *(u32x4*)(po + (size_t)rr * MLAW + 8 * cc) = *(const LAS u32x4*)(ot + rr * A2_LDO + 8 * cc); }
    if (hh == 0) p.PARTML[((size_t)kh * MP + qrow) * MH + h] = (f32x2){mrun, lrun};
    LDS_WAIT();
    __syncthreads();
}

constexpr int AS_LD = 592;
__device__ __forceinline__ s16x4 tr16(const LAS bf16_t* a) { return __builtin_bit_cast(s16x4, __builtin_amdgcn_ds_read_tr16_b64_v4i16((LAS s16x4*)a)); }
__device__ __forceinline__ void attn_sample_unit(const Prm& p, LAS unsigned char* lds, int b, int qq, int tid, int lane, int wave) {
    asm volatile("" : "+v"(tid), "+v"(lane));
    const int fr = lane & 15, fq = lane >> 4;
    LAS bf16_t* Ts = (LAS bf16_t*)lds;
    const int rgp = wave & 3, dh = wave >> 2; const int head = 2 * qq + (rgp >> 1), t0 = 16 * (rgp & 1);
    const int row = MP + b * 32 + t0 + fr;
    LAS bf16x8* QLs = (LAS bf16x8*)(lds + 64 * AS_LD * 2) + rgp * 16 * 64;
    LAS f32x4* XS = (LAS f32x4*)(lds + 64 * AS_LD * 2 + 65536);
    bf16x8 qrf[2];
    { bf16x8 qn[4];
#pragma unroll
      for (int ks = 0; ks < 4; ++ks) qn[ks] = *(const bf16x8*)(p.Q + (size_t)row * 1536 + head * QKH + 32 * ks + 8 * fq);
#pragma unroll
      for (int jj = 0; jj < 8; ++jj) { const int j = 8 * dh + jj; f32x4 a0 = {0.f, 0.f, 0.f, 0.f}, a1 = {0.f, 0.f, 0.f, 0.f};
          const bf16_t* w0 = p.WukN + (size_t)(32 * j + fr) * 1024 + head * 128 + 8 * fq; const bf16_t* w1 = w0 + (size_t)16 * 1024;
#pragma unroll
          for (int ks = 0; ks < 4; ++ks) { a0 = mfma16(*(const bf16x8*)(w0 + 32 * ks), qn[ks], a0); a1 = mfma16(*(const bf16x8*)(w1 + 32 * ks), qn[ks], a1); }
          QLs[j * 64 + lane] = pack8(a0, a1); if (jj & 1) __builtin_amdgcn_sched_barrier(0); }
#pragma unroll
      for (int ks = 0; ks < 2; ++ks) qrf[ks] = *(const bf16x8*)(p.Q + (size_t)row * 1536 + head * QKH + NOPE + 32 * ks + 8 * fq); }
    float mrun = -1e30f, lrun = 0.f; f32x4 o[16];
#pragma unroll
    for (int db = 0; db < 16; ++db) o[db] = (f32x4){0.f, 0.f, 0.f, 0.f};
    u32x4 treg[9];
    const int sr = tid >> 3, sc = tid & 7;
    const bf16_t* c_src = p.CACHE + ((size_t)b * PAST + sr) * CROW + sc * 8;
    auto issue = [&](int kt) {
        if (kt < 64) {
#pragma unroll
            for (int i = 0; i < 9; ++i) treg[i] = *(const u32x4*)(c_src + (size_t)kt * 64 * CROW + i * 64);
        } else if (sr < 32) {
#pragma unroll
            for (int i = 0; i < 8; ++i) treg[i] = *(const u32x4*)(p.CKVNs + (size_t)(b * 32 + sr) * KVL + sc * 8 + i * 64);
            treg[8] = *(const u32x4*)(p.KRb + (size_t)(MP + b * 32 + sr) * 64 + sc * 8);
        } else {
#pragma unroll
            for (int i = 0; i < 9; ++i) treg[i] = (u32x4){0u, 0u, 0u, 0u};
        }
    };
    issue(0);
    for (int kt = 0; kt < 65; ++kt) {
        { LAS bf16_t* td = Ts + sr * AS_LD + 32 * (sc >> 2) + 16 * (sc & 1) + 4 * ((sc >> 1) & 1);
#pragma unroll
          for (int i = 0; i < 8; ++i) { *(LAS u32x2*)(td + i * 64) = (u32x2){treg[i].x, treg[i].y}; *(LAS u32x2*)(td + i * 64 + 8) = (u32x2){treg[i].z, treg[i].w}; }
          *(LAS u32x4*)(Ts + sr * AS_LD + 512 + sc * 8) = treg[8]; }
        __syncthreads();
        if (kt + 1 < 65) issue(kt + 1);
        f32x4 s[4];
        { f32x4 so[2] = {(f32x4){0.f, 0.f, 0.f, 0.f}, (f32x4){0.f, 0.f, 0.f, 0.f}};
          const LAS bf16_t* tp = Ts + (32 * dh + fr) * AS_LD + 8 * fq;
          bf16x8 yv[2], xv[2];
#define AS_LDX(d, j) do { if ((j) < 18) xv[d] = *(const LAS bf16x8*)(tp + 16 * (d) * AS_LD + 32 * (j)); } while (0)
          yv[0] = QLs[lane];
          AS_LDX(0, 0); AS_LDX(1, 0);
          __builtin_amdgcn_s_setprio(1);
#pragma unroll
          for (int j = 0; j < 18; ++j) {
              if (j < 15) yv[(j + 1) & 1] = QLs[(j + 1) * 64 + lane];
#pragma unroll
              for (int d = 0; d < 2; ++d) { SB(); so[d] = mfma16(xv[d], j < 16 ? yv[j & 1] : qrf[j - 16], so[d]); AS_LDX(d, j + 1); SB(); } }
#undef AS_LDX
          __builtin_amdgcn_s_setprio(0);
          XS[((rgp * 2 + dh) * 2 + 0) * 64 + lane] = so[0]; XS[((rgp * 2 + dh) * 2 + 1) * 64 + lane] = so[1];
          __syncthreads();
          const f32x4 t0 = XS[((rgp * 2 + (dh ^ 1)) * 2 + 0) * 64 + lane], t1 = XS[((rgp * 2 + (dh ^ 1)) * 2 + 1) * 64 + lane];
#pragma unroll
          for (int e = 0; e < 4; ++e) { s[0][e] = dh ? t0[e] : so[0][e]; s[1][e] = dh ? t1[e] : so[1][e]; s[2][e] = dh ? so[0][e] : t0[e]; s[3][e] = dh ? so[1][e] : t1[e]; }
        }
        if (kt == 64) { s[2] = (f32x4){-1e30f, -1e30f, -1e30f, -1e30f}; s[3] = s[2]; }
        float mx = fmaxf(fmaxf(fmaxf(s[0][0], s[0][1]), fmaxf(s[0][2], s[0][3])), fmaxf(fmaxf(s[1][0], s[1][1]), fmaxf(s[1][2], s[1][3])));
        mx = fmaxf(mx, fmaxf(fmaxf(fmaxf(s[2][0], s[2][1]), fmaxf(s[2][2], s[2][3])), fmaxf(fmaxf(s[3][0], s[3][1]), fmaxf(s[3][2], s[3][3]))));
        mx = fmaxf(mx, __shfl_xor(mx, 16)); mx = fmaxf(mx, __shfl_xor(mx, 32));
        const float mnew = fmaxf(mrun, mx), alpha = __builtin_amdgcn_exp2f(mrun - mnew); mrun = mnew;
        float ps = 0.f;
#pragma unroll
        for (int kb = 0; kb < 4; ++kb)
#pragma unroll
            for (int rg = 0; rg < 4; ++rg) { s[kb][rg] = __builtin_amdgcn_exp2f(s[kb][rg] - mnew); ps += s[kb][rg]; }
        lrun = lrun * alpha + ps;
        const bf16x8 pf0 = pack8(s[0], s[1]), pf1 = pack8(s[2], s[3]);
        const LAS bf16_t* tb = Ts + (4 * fq + (fr >> 2)) * AS_LD + 256 * dh + 4 * (fr & 3);
        { s16x4 tv[2][4];
#define AS_LDT(buf, db) do { _Pragma("unroll") for (int i = 0; i < 4; ++i) tv[buf][i] = tr16(tb + 16 * i * AS_LD + 16 * (db)); } while (0)
          AS_LDT(0, 0); AS_LDT(1, 1);
          __builtin_amdgcn_s_setprio(1);
#pragma unroll
          for (int db = 0; db < 16; ++db) {
              SB();
              const s16x4 x0 = tv[db & 1][0], x1 = tv[db & 1][1], x2 = tv[db & 1][2], x3 = tv[db & 1][3];
              o[db] = o[db] * alpha;
              o[db] = mfma16((bf16x8){x0[0], x0[1], x0[2], x0[3], x1[0], x1[1], x1[2], x1[3]}, pf0, o[db]);
              o[db] = mfma16((bf16x8){x2[0], x2[1], x2[2], x2[3], x3[0], x3[1], x3[2], x3[3]}, pf1, o[db]);
              if (db < 14) AS_LDT(db & 1, db + 2);
              SB(); }
          __builtin_amdgcn_s_setprio(0);
#undef AS_LDT
        }
        __syncthreads();
    }
    lrun += __shfl_xor(lrun, 16); lrun += __shfl_xor(lrun, 32);
    const float inv = 1.f / lrun;
    bf16x8 cf[8];
#pragma unroll
    for (int j = 0; j < 8; ++j) cf[j] = pack8(o[2 * j] * inv, o[2 * j + 1] * inv);
    f32x4 r8[8];
#pragma unroll
    for (int ddb = 0; ddb < 8; ++ddb) { r8[ddb] = (f32x4){0.f, 0.f, 0.f, 0.f};
        const bf16_t* wp = p.WuvT + (size_t)(head * 128 + 16 * ddb + fr) * KVL + 256 * dh + 16 * (fq & 1) + 4 * (fq >> 1);
#pragma unroll
        for (int j = 0; j < 8; ++j) { const u32x2 wa = *(const u32x2*)(wp + 32 * j), wb = *(const u32x2*)(wp + 32 * j + 8); r8[ddb] = mfma16(__builtin_bit_cast(bf16x8, (u32x4){wa.x, wa.y, wb.x, wb.y}), cf[j], r8[ddb]); }
        __builtin_amdgcn_sched_barrier(0); }
    LAS f32x4* xch = (LAS f32x4*)lds + (rgp * 8) * 64 + lane;
    if (dh == 1) {
#pragma unroll
        for (int ddb = 0; ddb < 8; ++ddb) xch[ddb * 64] = r8[ddb];
    }
    __syncthreads();
    if (dh == 0) {
#pragma unroll
        for (int ddb = 0; ddb < 8; ++ddb) { const f32x4 v = r8[ddb] + xch[ddb * 64];
            *(u32x2*)(p.ACat + (size_t)row * DM + MLAW + head * VH + 16 * ddb + 4 * fq) = (u32x2){pk2(v[0], v[1]), pk2(v[2], v[3])}; }
    }
    __syncthreads();
}

template <int MODE = 7> __device__ __forceinline__ void phase3(const Prm& p, LAS unsigned char* lds, int tid, int lane, int wave) {
    if (MODE & 4) ret_scan(p, tid);
    if (gridDim.x == 256) {
        for (int i = 0; i < P3_MAXU; ++i) {
            const int u = p3_sched[blockIdx.x][i]; if (u == 0xFFFF) break;
            if (u < 128) { if (MODE & 1) attn_sample_unit(p, lds, u >> 2, u & 3, tid, lane, wave); }
            else if (MODE & 2) { const int v = u - 128; attn_prompt_unit2(p, lds, v >> 4, (v >> 1) & 7, v & 1, tid, lane, wave); }
        }
        return;
    }
    const int G = (int)gridDim.x, c = (int)blockIdx.x;
    for (int u = c; u < 128 + 512; u += G) {
        if ((MODE & 1) && u < 128) attn_sample_unit(p, lds, u >> 2, u & 3, tid, lane, wave);
        if ((MODE & 2) && u >= 128) { const int v = u - 128; attn_prompt_unit(p, lds, 63 - (v >> 3), v & 7, tid, lane, wave); }
    }
}

__device__ __forceinline__ float silu_f(float x) { return x / (1.f + __expf(-x)); }
template <int L> __device__ __forceinline__ void ret_stepC(const Prm& p, int cid, int hp, int lane, int wave) {
    asm volatile("" : "+v"(lane));
    constexpr int NLB = L / 16;
    const int fr = lane & 15, fq = lane >> 4;
    const int lb = wave % NLB, h = (L == 64 ? 2 * hp : 0) + wave / NLB;
    const int row0 = (L == 64) ? cid * 64 : MP + (cid - 128) * 32;
    const int row = row0 + 16 * lb + fr;
    const bf16_t* Sp = (L == 64) ? p.SPREV + (size_t)(cid * 4 + h) * 65536 : p.S0T + (size_t)((cid - 128) * 4 + h) * 65536;
    bf16x8 qf[8];
    { const bf16_t* qp = p.RQ + (size_t)row * RW + h * 256 + 8 * fq;
#pragma unroll
      for (int ks = 0; ks < 8; ++ks) qf[ks] = *(const bf16x8*)(qp + 32 * ks); }
    const float inner = __builtin_amdgcn_exp2f((float)(16 * lb + fr + 1) * lg2gamma(h));
    f32x4 o[16]; float sum = 0.f;
#pragma unroll
    for (int vg = 0; vg < 8; ++vg) {
        bf16x8 sf[2][8]; f32x4 it[2];
#pragma unroll
        for (int d = 0; d < 2; ++d) { const bf16_t* sp = Sp + (size_t)(16 * (2 * vg + d) + fr) * 256 + 8 * fq;
#pragma unroll
            for (int ks = 0; ks < 8; ++ks) sf[d][ks] = *(const bf16x8*)(sp + 32 * ks);
            it[d] = *(const f32x4*)(p.OINTRA + (size_t)row * RW + h * 256 + 16 * (2 * vg + d) + 4 * fq); }
        __builtin_amdgcn_sched_barrier(0);
#pragma unroll
        for (int d = 0; d < 2; ++d) { const int vb = 2 * vg + d; f32x4 a = {0.f, 0.f, 0.f, 0.f};
#pragma unroll
            for (int ks = 0; ks < 8; ++ks) a = mfma16(sf[d][ks], qf[ks], a);
            o[vb] = a * inner + it[d]; sum += (o[vb][0] + o[vb][1]) + (o[vb][2] + o[vb][3]); }
        __builtin_amdgcn_sched_barrier(0);
    }
    sum += __shfl_xor(sum, 16); sum += __shfl_xor(sum, 32);
    const float mu = sum * (1.f / 256.f); float vs = 0.f;
#pragma unroll
    for (int vb = 0; vb < 16; ++vb) { o[vb] = o[vb] - mu; vs += (o[vb][0] * o[vb][0] + o[vb][1] * o[vb][1]) + (o[vb][2] * o[vb][2] + o[vb][3] * o[vb][3]); }
    vs += __shfl_xor(vs, 16); vs += __shfl_xor(vs, 32);
    const float rstd = rsqrtf(vs * (1.f / 256.f) + EPS);
#pragma unroll
    for (int vb = 0; vb < 16; ++vb) {
        const int col = h * 256 + 16 * vb + 4 * fq;
        const f32x4 g = *(const f32x4*)(p.in[14] + col); const u32x2 rgw = *(const u32x2*)(p.RG + (size_t)row * RW + col);
        const float y0 = o[vb][0] * rstd * g[0] * silu_f(bflo(rgw.x)), y1 = o[vb][1] * rstd * g[1] * silu_f(bfhi(rgw.x));
        const float y2 = o[vb][2] * rstd * g[2] * silu_f(bflo(rgw.y)), y3 = o[vb][3] * rstd * g[3] * silu_f(bfhi(rgw.y));
        *(u32x2*)(p.ACat + (size_t)row * DM + col) = (u32x2){pk2(y0, y1), pk2(y2, y3)};
    }
}
__device__ __forceinline__ void mla_norm_pass(const Prm& p, int lane, int wave) {
    const int gw = blockIdx.x * NWAVES + wave, NGW = gridDim.x * NWAVES;
    for (int row = gw; row < MT; row += NGW) {
        bf16_t* base = p.ACat + (size_t)row * DM + MLAW + 8 * lane;
        float v[16];
        if (row < MP) {
#pragma unroll
            for (int k = 0; k < 2; ++k) { const int c0 = 8 * lane + 512 * k, head = c0 >> 7;
                const u32x4 a = *(const u32x4*)(p.PARTO + (size_t)row * MLAW + c0), b = *(const u32x4*)(p.PARTO + ((size_t)MP + row) * MLAW + c0);
                const f32x2 ml1 = p.PARTML[(size_t)row * MH + head], ml2 = p.PARTML[((size_t)MP + row) * MH + head];
                const float m = fmaxf(ml1.x, ml2.x); const float w1 = ml1.y * __builtin_amdgcn_exp2f(ml1.x - m), w2 = ml2.y * __builtin_amdgcn_exp2f(ml2.x - m);
                const float iw = 1.f / (w1 + w2), f1 = w1 * iw, f2 = w2 * iw;
                v[8 * k + 0] = bflo(a.x) * f1 + bflo(b.x) * f2; v[8 * k + 1] = bfhi(a.x) * f1 + bfhi(b.x) * f2; v[8 * k + 2] = bflo(a.y) * f1 + bflo(b.y) * f2; v[8 * k + 3] = bfhi(a.y) * f1 + bfhi(b.y) * f2;
                v[8 * k + 4] = bflo(a.z) * f1 + bflo(b.z) * f2; v[8 * k + 5] = bfhi(a.z) * f1 + bfhi(b.z) * f2; v[8 * k + 6] = bflo(a.w) * f1 + bflo(b.w) * f2; v[8 * k + 7] = bfhi(a.w) * f1 + bfhi(b.w) * f2; }
        } else {
            const u32x4 z0 = *(const u32x4*)base, z1 = *(const u32x4*)(base + 512);
            v[0] = bflo(z0.x); v[1] = bfhi(z0.x); v[2] = bflo(z0.y); v[3] = bfhi(z0.y); v[4] = bflo(z0.z); v[5] = bfhi(z0.z); v[6] = bflo(z0.w); v[7] = bfhi(z0.w);
            v[8] = bflo(z1.x); v[9] = bfhi(z1.x); v[10] = bflo(z1.y); v[11] = bfhi(z1.y); v[12] = bflo(z1.z); v[13] = bfhi(z1.z); v[14] = bflo(z1.w); v[15] = bfhi(z1.w);
        }
        float s = 0.f;
#pragma unroll
        for (int j = 0; j < 16; ++j) s += v[j] * v[j];
        const float r = rsqrtf(wave_sum(s) * (1.f / MLAW) + EPS);
        const float* g = p.in[15] + 8 * lane;
#pragma unroll
        for (int j = 0; j < 16; ++j) v[j] = v[j] * r * g[(j >> 3) * 512 + (j & 7)];
        *(u32x4*)base = (u32x4){pk2(v[0], v[1]), pk2(v[2], v[3]), pk2(v[4], v[5]), pk2(v[6], v[7])};
        *(u32x4*)(base + 512) = (u32x4){pk2(v[8], v[9]), pk2(v[10], v[11]), pk2(v[12], v[13]), pk2(v[14], v[15])};
    }
}
__device__ __forceinline__ void phase4(const Prm& p, LAS unsigned char* lds, int tid, int lane, int wave) {
    const int G = (int)gridDim.x, c = (int)blockIdx.x;
    { int t2 = lane_id(); asm volatile("" : "+v"(t2)); lane = t2; }
    mla_norm_pass(p, lane, wave);
    for (int u = c; u < 256 + 32; u += G) {
        if (u < 256) ret_stepC<64>(p, u >> 1, u & 1, lane, wave); else ret_stepC<32>(p, 128 + (u - 256), 0, lane, wave);
    }
}

template <int NB = 2> struct EpiH1T {
    static constexpr bool PERM = true, AFTER_DRAIN = false;
    Prm p;
    __device__ __forceinline__ void operator()(const f32x4 (&acc)[2][2][4][2], const pg8::Unit& u, int wr, int wc, int fr, int fq) const {
        const int ci = u.pn * 256 + 32 * wc + 8 * fq;
        f32x4 gg[2][2];
#pragma unroll
        for (int bj = 0; bj < 2; ++bj) { gg[bj][0] = *(const f32x4*)(p.in[17] + 128 * bj + ci); gg[bj][1] = *(const f32x4*)(p.in[17] + 128 * bj + ci + 4); }
#pragma unroll
        for (int am = 0; am < 8 / NB; ++am) { const int ai = (am * NB) >> 2;
            f32x4 xv[NB][2][2];
#pragma unroll
            for (int mm = 0; mm < NB; ++mm) { const float* xr = xrow(p, u.pm * 256 + ai * 128 + wr * 64 + (((am * NB) & 3) + mm) * 16 + fr);
#pragma unroll
                for (int bj = 0; bj < 2; ++bj) { xv[mm][bj][0] = *(const f32x4*)(xr + 128 * bj + ci); xv[mm][bj][1] = *(const f32x4*)(xr + 128 * bj + ci + 4); } }
            __builtin_amdgcn_sched_barrier(0);
#pragma unroll
            for (int mm = 0; mm < NB; ++mm) { const int m = ((am * NB) & 3) + mm;
                const int row = u.pm * 256 + ai * 128 + wr * 64 + m * 16 + fr; float s = 0.f;
#pragma unroll
                for (int bj = 0; bj < 2; ++bj) { const int col = 128 * bj + ci;
                    const f32x4 a = acc[ai][bj][m][0] + xv[mm][bj][0], b = acc[ai][bj][m][1] + xv[mm][bj][1];
                    *(f32x4*)(p.H1 + (size_t)row * DM + col) = a; *(f32x4*)(p.H1 + (size_t)row * DM + col + 4) = b;
                    s += (a[0] * a[0] + a[1] * a[1]) + (a[2] * a[2] + a[3] * a[3]) + (b[0] * b[0] + b[1] * b[1]) + (b[2] * b[2] + b[3] * b[3]);
                    const f32x4 g0 = gg[bj][0], g1 = gg[bj][1];
                    *(u32x4*)(p.XN + (size_t)row * DM + col) = (u32x4){pk2(a[0] * g0[0], a[1] * g0[1]), pk2(a[2] * g0[2], a[3] * g0[3]), pk2(b[0] * g1[0], b[1] * g1[1]), pk2(b[2] * g1[2], b[3] * g1[3])}; }
                s += __shfl_xor(s, 16); s += __shfl_xor(s, 32); if (fq == 0) p.ssq2[(size_t)row * 32 + u.pn * 4 + wc] = s;
            }
        }
    }
};
typedef EpiH1T<2> EpiH1;
__device__ __forceinline__ float row_rs32(const float* ssq, int row) {
    const f32x4* q = (const f32x4*)(ssq + (size_t)row * 32); float s = 0.f;
#pragma unroll
    for (int j = 0; j < 8; ++j) { const f32x4 v = q[j]; s += (v.x + v.y) + (v.z + v.w); }
    return rsqrtf(s * (1.f / DM) + EPS);
}
struct EpiSC {
    static constexpr bool PERM = true, AFTER_DRAIN = false;
    Prm p;
    __device__ __forceinline__ void operator()(const f32x4 (&acc)[2][2][4][2], const pg8::Unit& u, int wr, int wc, int fr, int fq) const {
        const int ci = u.pn * 256 + 32 * wc + 8 * fq;
        float rr[2][4];
#pragma unroll
        for (int ai = 0; ai < 2; ++ai)
#pragma unroll
            for (int m = 0; m < 4; ++m) rr[ai][m] = row_rs32(p.ssq2, u.pm * 256 + ai * 128 + wr * 64 + m * 16 + fr);
#pragma unroll
        for (int ai = 0; ai < 2; ++ai)
#pragma unroll
            for (int m = 0; m < 4; ++m) {
                const int row = u.pm * 256 + ai * 128 + wr * 64 + m * 16 + fr; const float r = rr[ai][m];
#pragma unroll
                for (int bj = 0; bj < 2; ++bj) { float* d = p.SC + (size_t)row * DM + 128 * bj + ci; *(f32x4*)d = acc[ai][bj][m][0] * r; *(f32x4*)(d + 4) = acc[ai][bj][m][1] * r; }
            }
    }
};
struct EpiGate {
    static constexpr bool PERM = true, AFTER_DRAIN = false;
    Prm p;
    __device__ __forceinline__ void operator()(const f32x4 (&acc)[2][2][4][2], const pg8::Unit& u, int wr, int wc, int fr, int fq) const {
        const int ci = u.pn * 256 + 32 * wc + 8 * fq;
#pragma unroll
        for (int am = 0; am < 4; ++am) { const int ai = am >> 1;
            f32x4 hv[2][2][2]; u32x4 pv[2][2];
#pragma unroll
            for (int mm = 0; mm < 2; ++mm) { const size_t ro = (size_t)(u.pm * 256 + ai * 128 + wr * 64 + (2 * (am & 1) + mm) * 16 + fr) * DM;
#pragma unroll
                for (int bj = 0; bj < 2; ++bj) { const int col = 128 * bj + ci; hv[mm][bj][0] = *(const f32x4*)(p.H1 + ro + col); hv[mm][bj][1] = *(const f32x4*)(p.H1 + ro + col + 4); pv[mm][bj] = *(const u32x4*)(p.PP + ro + col); } }
            __builtin_amdgcn_sched_barrier(0);
#pragma unroll
            for (int mm = 0; mm < 2; ++mm) { const int m = 2 * (am & 1) + mm;
                const int row = u.pm * 256 + ai * 128 + wr * 64 + m * 16 + fr; float s = 0.f;
#pragma unroll
                for (int bj = 0; bj < 2; ++bj) { const int col = 128 * bj + ci;
                    const u32x4 pw = pv[mm][bj];
                    const float pp[8] = {bflo(pw.x), bfhi(pw.x), bflo(pw.y), bfhi(pw.y), bflo(pw.z), bfhi(pw.z), bflo(pw.w), bfhi(pw.w)};
                    f32x4 a = hv[mm][bj][0], b = hv[mm][bj][1];
#pragma unroll
                    for (int e = 0; e < 4; ++e) { a[e] += pp[e] / (1.f + __expf(-acc[ai][bj][m][0][e])); b[e] += pp[4 + e] / (1.f + __expf(-acc[ai][bj][m][1][e])); }
                    *(f32x4*)(p.out + O_Y + (size_t)row * DM + col) = a; *(f32x4*)(p.out + O_Y + (size_t)row * DM + col + 4) = b;
                    s += (a[0] * a[0] + a[1] * a[1]) + (a[2] * a[2] + a[3] * a[3]) + (b[0] * b[0] + b[1] * b[1]) + (b[2] * b[2] + b[3] * b[3]); }
                s += __shfl_xor(s, 16); s += __shfl_xor(s, 32); if (fq == 0) p.ssq3[(size_t)row * 32 + u.pn * 4 + wc] = s;
            }
        }
    }
};
struct RangeOrder {
    int nM, nN, nwg, G, c, L0, L1, pm_off, wv = 0;
    __device__ __forceinline__ void init(int M, int N, int G_, int c_, int L0_, int L1_, int pm_off_) { nM = M / pg8::BM; nN = N / pg8::BM; nwg = nM * nN; G = G_; c = c_; L0 = L0_; L1 = L1_; pm_off = pm_off_; }
    __device__ __forceinline__ bool next(int i, pg8::Unit& u) const {
        const long L = (long)L0 + (long)i * G + c; if (c < 0 || c >= G || L >= L1) return false;
        int wgid = (int)L; { const int q = nwg / pg8::NXCD, r = nwg % pg8::NXCD, xcd = wgid % pg8::NXCD, off = wgid / pg8::NXCD; wgid = (xcd < r ? xcd * (q + 1) : r * (q + 1) + (xcd - r) * q) + off; }
        const int nig = pg8::WGM * nN, gid = wgid / nig, fm = gid * pg8::WGM, gsz = (nM - fm) < pg8::WGM ? (nM - fm) : pg8::WGM;
        u.pm = fm + ((wgid % nig) % gsz) + pm_off; u.pn = (wgid % nig) / gsz; return true;
    }
    __device__ __forceinline__ void a_ready(const pg8::Unit&) const {}
    __device__ __forceinline__ void done(const pg8::Unit&) const {}
};
template <class Epi> __device__ __forceinline__ void gemm_range(const Prm& p, LAS unsigned char* lds, const bf16_t* A, const bf16_t* Bt, const Epi& E, int Msub, int G, int c, int L0, int L1, int pm_off, int wave) {
    pg8::Gemm g{A, Bt, MT, DM, DM}; RangeOrder S; S.init(Msub, DM, G, c, L0, L1, pm_off); S.wv = wave;
    pg8::gemm_phase<Epi, RangeOrder, true, true>(lds, g, S, E);
}
__device__ __forceinline__ void final_norm_rows(const Prm& p, int row0, int row1, int gw, int NGW, int lane) {
    for (int row = row0 + gw; row < row1; row += NGW) {
        const float r = row_rs32(p.ssq3, row);
        f32x4* y = (f32x4*)(p.out + O_Y + (size_t)row * DM) + lane; const f32x4* g = (const f32x4*)p.in[25] + lane;
#pragma unroll
        for (int j = 0; j < 8; ++j) { const f32x4 v = y[64 * j], gg = g[64 * j]; y[64 * j] = (f32x4){v.x * r * gg.x, v.y * r * gg.y, v.z * r * gg.z, v.w * r * gg.w}; }
    }
}
__device__ __forceinline__ void phase5a(const Prm& p, LAS unsigned char* lds, int tid, int lane, int wave) {
    EpiH1 E{p}; gemm_range<EpiH1>(p, lds, p.ACat, p.WoutT, E, MP, (int)gridDim.x, (int)blockIdx.x, 0, 256, 0, wave);
}
__device__ __forceinline__ void phase5b(const Prm& p, LAS unsigned char* lds, int tid, int lane, int wave) {
    int c = (int)blockIdx.x; asm volatile("" : "+s"(c)); const int G = (int)gridDim.x;
    if (c < 32) { EpiH1T<1> E{p}; gemm_range<EpiH1T<1>>(p, lds, p.ACat, p.WoutT, E, MS, 32, c, 0, 32, 32, wave); }
    else { EpiSC E{p}; gemm_range<EpiSC>(p, lds, p.XN, p.WsT, E, MP, G - 32, c - 32, 0, G - 32, 0, wave); }
}
__device__ __forceinline__ void phase6c(const Prm& p, LAS unsigned char* lds, int tid, int lane, int wave) {
    int c = (int)blockIdx.x; asm volatile("" : "+s"(c)); const int G = (int)gridDim.x;
    if (c < 32) { EpiSC E{p}; gemm_range<EpiSC>(p, lds, p.XN, p.WsT, E, MP, 32, c, G - 32, 256, 0, wave); }
    else if (c < 64) { EpiSC E{p}; gemm_range<EpiSC>(p, lds, p.XN, p.WsT, E, MS, 32, c - 32, 0, 32, 32, wave); }
    else {
        { int t2 = lane_id(); asm volatile("" : "+v"(t2)); expert_tables_fp8(p, (c - 64) * NWAVES + wave, (G - 64) * NWAVES, t2); }
        int kk = PLE; asm volatile("" : "+s"(kk));
        pg8::Gemm g2{p.Pb, p.WpT, MT, DM, kk}; pg8::StaticOrder S2; S2.init(MT, DM, G - 64, c - 64); S2.wv = wave; EpiPP E2{p.PP, DM}; pg8::gemm_phase<EpiPP, pg8::StaticOrder, true, true>(lds, g2, S2, E2);
    }
}
__device__ __forceinline__ void phase8a(const Prm& p, LAS unsigned char* lds, int tid, int lane, int wave) {
    EpiGate E{p}; gemm_range<EpiGate>(p, lds, p.XN, p.WgT, E, MP, (int)gridDim.x, (int)blockIdx.x, 0, 256, 0, wave);
}
__device__ __forceinline__ void phase8b(const Prm& p, LAS unsigned char* lds, int tid, int lane, int wave) {
    const int c = (int)blockIdx.x, G = (int)gridDim.x;
    if (c < 32) { EpiGate E{p}; gemm_range<EpiGate>(p, lds, p.XN, p.WgT, E, MS, 32, c, 0, 32, 32, wave); }
    else { int t2 = lane_id(); asm volatile("" : "+v"(t2)); final_norm_rows(p, 0, MP, (c - 32) * NWAVES + wave, (G - 32) * NWAVES, t2); }
}
__device__ __forceinline__ void phase9s(const Prm& p, LAS unsigned char* lds, int tid, int lane, int wave) {
    final_norm_rows(p, MP, MT, (int)blockIdx.x * NWAVES + wave, (int)gridDim.x * NWAVES, lane);
}

typedef __bf16 v2bf __attribute__((ext_vector_type(2)));
__device__ __forceinline__ float dot2bf(unsigned a, unsigned b, float c) { return __builtin_amdgcn_fdot2_f32_bf16(__builtin_bit_cast(v2bf, a), __builtin_bit_cast(v2bf, b), c, false); }
__device__ __forceinline__ unsigned sortkey(float f, unsigned idx) { unsigned u = __float_as_uint(f); u = (u & 0x80000000u) ? ~u : (u | 0x80000000u); return (u & ~127u) | (127u - idx); }
__device__ __forceinline__ float gelu_erf(float v) {
    const float av = fabsf(v), t = __builtin_amdgcn_rcpf(av * 0.2316418882f + 1.0f);
    float q = t * 0.5307027145f + (-0.7265760135f); q = q * t + 0.7107068705f; q = q * t + (-0.142248368f); q = q * t + 0.127414796f; q = q * t;
    const float e = __builtin_amdgcn_exp2f((v * v) * (-0.72134752044f)); const float m = v * (q * e);
    return v < 0.f ? m : v - m;
}

template <int PMODE = 0> __device__ __forceinline__ void phase7(const Prm& p, LAS unsigned char* lds, int tid, int lane, int wave) {
    constexpr bool COMMIT = PMODE == 0; constexpr int PEER_AUX = 0;
    constexpr int PAIRSZ = 30720, SLOT0 = 1152, SLOTSZ = 6400, OB0 = SLOT0 + 2 * SLOTSZ, OBSZ = 8192;
    const int pr = wave & 3; const bool producer = wave < 4;
    const int gp = blockIdx.x * 4 + pr, NGP = gridDim.x * 4;
    const int ntot = (MT - gp + NGP - 1) / NGP;
    LAS unsigned char* pb = lds + pr * PAIRSZ;
    LAS unsigned* wl = (LAS unsigned*)pb;
    LAS unsigned* skey = wl;
    LAS float* tv = (LAS float*)(wl + 128);
    LAS int* ti = (LAS int*)(wl + 160);
    LAS unsigned* ckey = wl + 192;
    LAS volatile unsigned* flg = (LAS volatile unsigned*)(pb + 1024);
    if (producer && lane == 0) { flg[0] = 0u; flg[1] = 0u; flg[2] = 0u; flg[3] = 0u; }
    __syncthreads();
    if (producer) {
    int ca = 0, cb = 0; const bool cvalid = lane < 50;
    { int base = 0; bool found = false;
#pragma unroll
      for (int a = 0; a < 16; ++a) { const int nb = 16 / (a + 1); if (!found && lane < base + nb) { ca = a; cb = lane - base; found = true; } base += nb; } }
    if (!cvalid) { ca = 0; cb = 0; }
    int epi = 0;
    for (int nt = 0; nt <= ntot; ++nt) {
        const int row = gp + nt * NGP; const bool live = nt < ntot;
        LAS unsigned char* slot = pb + SLOT0 + (nt & 1) * SLOTSZ;
        LAS int* exi = (LAS int*)slot; LAS float* exs = (LAS float*)(slot + 544);
        float sa[16], sb[16];
        u32x4 mraw[4]; float r2 = 0.f;
        if (live) { const float* sc = p.SC + (size_t)row * DM;
#pragma unroll
            for (int g = 0; g < 16; ++g) { sa[g] = __builtin_nontemporal_load(sc + g * 128 + lane); sb[g] = __builtin_nontemporal_load(sc + g * 128 + 64 + lane); }
#pragma unroll
            for (int q = 0; q < 4; ++q) mraw[q] = __builtin_nontemporal_load((const u32x4*)(p.XN + (size_t)row * DM + 32 * lane + 8 * q));
            r2 = row_rs32(p.ssq2, row); }
        for (;;) {
            const int fin = __builtin_amdgcn_readfirstlane((int)flg[2]);
            if (epi < fin) {
                asm volatile("" ::: "memory");
                const int erow = gp + epi * NGP; const LAS f32x4* ob = (const LAS f32x4*)(pb + OB0 + (epi & 1) * OBSZ);
                float ss = 0.f; f32x4 hv4[8];
#pragma unroll
                for (int q = 0; q < 8; ++q) { float* hp = p.H1 + (size_t)erow * DM + 32 * lane + 4 * q;
                    f32x4 a = __builtin_nontemporal_load((const f32x4*)hp); const f32x4 o = ob[q * 64 + lane]; a += o; hv4[q] = a; ss += (a.x * a.x + a.y * a.y) + (a.z * a.z + a.w * a.w);
                    if (COMMIT) __builtin_nontemporal_store(a, (f32x4*)hp); }
                LDS_WAIT();
                if (lane == 0) flg[3] = (unsigned)(epi + 1);
                const float r3 = rsqrtf(wave_sum(ss) * (1.f / DM) + EPS);
#pragma unroll
                for (int q = 0; q < 4; ++q) { const float* g = p.in[22] + 32 * lane + 8 * q; const f32x4 ga = *(const f32x4*)g, gb = *(const f32x4*)(g + 4); const f32x4 x0 = hv4[2 * q], x1 = hv4[2 * q + 1];
                    u32x4* xo = COMMIT ? (u32x4*)(p.XN + (size_t)erow * DM + 32 * lane + 8 * q) : (u32x4*)p.OINTRA + (size_t)(blockIdx.x * 512 + wave * 64 + lane);
                    *xo = (u32x4){pk2(x0.x * r3 * ga[0], x0.y * r3 * ga[1]), pk2(x0.z * r3 * ga[2], x0.w * r3 * ga[3]), pk2(x1.x * r3 * gb[0], x1.y * r3 * gb[1]), pk2(x1.z * r3 * gb[2], x1.w * r3 * gb[3])}; }
                ++epi; continue;
            }
            const bool go = live ? (nt - __builtin_amdgcn_readfirstlane((int)flg[1]) < 2) : (epi >= ntot);
            if (go) break;
            __builtin_amdgcn_s_sleep(2);
        }
        if (!live) break;
        asm volatile("" ::: "memory");
        { LAS u32x4* mo = (LAS u32x4*)(slot + 2304);
#pragma unroll
          for (int q = 0; q < 4; ++q) mo[q * 64 + lane] = mraw[q];
          if (lane == 0) *(LAS float*)(slot + 2176) = r2; }
#pragma unroll
        for (int hh = 0; hh < PH; ++hh) {
            const float a0[2] = {sa[2 * hh], sa[2 * hh + 1]}, a1[2] = {sb[2 * hh], sb[2 * hh + 1]};
            const unsigned k0[2] = {sortkey(a0[0], lane), sortkey(a0[1], lane)}, k1[2] = {sortkey(a1[0], 64 + lane), sortkey(a1[1], 64 + lane)};
            unsigned T0 = 0u, T1 = 0u, bm = 0x80000000u; int n0 = 128, n1 = 128;
#pragma unroll 1
            do { const unsigned c0 = T0 | bm, c1 = T1 | bm; bm >>= 1;
                const int cnt0 = __builtin_popcountll(__builtin_amdgcn_ballot_w64(k0[0] >= c0)) + __builtin_popcountll(__builtin_amdgcn_ballot_w64(k1[0] >= c0));
                const int cnt1 = __builtin_popcountll(__builtin_amdgcn_ballot_w64(k0[1] >= c1)) + __builtin_popcountll(__builtin_amdgcn_ballot_w64(k1[1] >= c1));
                T0 = (unsigned)__builtin_amdgcn_readfirstlane((int)(cnt0 >= 16 ? c0 : T0)); n0 = __builtin_amdgcn_readfirstlane(cnt0 >= 16 ? cnt0 : n0);
                T1 = (unsigned)__builtin_amdgcn_readfirstlane((int)(cnt1 >= 16 ? c1 : T1)); n1 = __builtin_amdgcn_readfirstlane(cnt1 >= 16 ? cnt1 : n1);
            } while (n0 + n1 != 32);
#pragma unroll
            for (int half = 0; half < 2; ++half) {
                const unsigned T = half ? T1 : T0;
                const bool s0 = k0[half] >= T, s1 = k1[half] >= T;
                const unsigned long long b0 = __builtin_amdgcn_ballot_w64(s0), b1 = __builtin_amdgcn_ballot_w64(s1);
                const int below0 = __builtin_amdgcn_mbcnt_hi((unsigned)(b0 >> 32), __builtin_amdgcn_mbcnt_lo((unsigned)b0, 0u));
                const int below1 = __builtin_popcountll(b0) + __builtin_amdgcn_mbcnt_hi((unsigned)(b1 >> 32), __builtin_amdgcn_mbcnt_lo((unsigned)b1, 0u));
                LAS unsigned* sk = skey + half * 48;
                if (s0) { sk[below0] = k0[half]; sk[16 + below0] = __float_as_uint(a0[half]); sk[32 + below0] = (unsigned)lane; }
                if (s1) { sk[below1] = k1[half]; sk[16 + below1] = __float_as_uint(a1[half]); sk[32 + below1] = (unsigned)(64 + lane); }
            }
            LDS_WAIT();
            if (lane < 32) { const int half = lane >> 4, l16 = lane & 15; const LAS unsigned* sk = skey + half * 48; const unsigned mine = sk[l16]; int rk = 0;
#pragma unroll
                for (int j4 = 0; j4 < 4; ++j4) { const u32x4 v = ((const LAS u32x4*)sk)[j4]; rk += (int)(v.x > mine) + (int)(v.y > mine) + (int)(v.z > mine) + (int)(v.w > mine); }
                tv[half * 16 + rk] = __uint_as_float(sk[16 + l16]); ti[half * 16 + rk] = (int)sk[32 + l16]; }
            LDS_WAIT();
            const float cv = cvalid ? tv[ca] + tv[16 + cb] : -3.0e38f;
            const unsigned ck = sortkey(cv, lane);
            unsigned T = 0u, bmc = 0x80000000u; int cnt;
#pragma unroll 1
            do { const unsigned cand = T | bmc; bmc >>= 1; cnt = __builtin_popcountll(__builtin_amdgcn_ballot_w64(ck >= cand));
                T = (unsigned)__builtin_amdgcn_readfirstlane((int)(cnt >= 16 ? cand : T)); } while (cnt != 16);
            const bool sc_ = ck >= T;
            const unsigned long long bc = __builtin_amdgcn_ballot_w64(sc_);
            const int belowc = __builtin_amdgcn_mbcnt_hi((unsigned)(bc >> 32), __builtin_amdgcn_mbcnt_lo((unsigned)bc, 0u));
            if (sc_) { ckey[belowc] = ck; ckey[16 + belowc] = __float_as_uint(cv); ckey[32 + belowc] = (unsigned)(ti[ca] * NKEYS + ti[16 + cb]); }
            LDS_WAIT();
            if (lane < 16) { const unsigned mine = ckey[lane]; int rk = 0;
#pragma unroll
                for (int j4 = 0; j4 < 4; ++j4) { const u32x4 v = ((const LAS u32x4*)ckey)[j4]; rk += (int)(v.x > mine) + (int)(v.y > mine) + (int)(v.z > mine) + (int)(v.w > mine); }
                exi[hh * 16 + rk] = (int)ckey[32 + lane]; exs[hh * 16 + rk] = __uint_as_float(ckey[16 + lane]); }
            LDS_WAIT();
        }
        { LAS float* wt = (LAS float*)skey;
          const float s0 = exs[lane], s1 = exs[64 + lane], m0 = exs[lane & ~15], m1 = exs[64 + (lane & ~15)];
          const float w0 = __expf(s0 - m0), w1 = __expf(s1 - m1);
          wt[lane] = w0; wt[64 + lane] = w1; LDS_WAIT();
          float t0 = 0.f, t1 = 0.f;
#pragma unroll
          for (int j = 0; j < 4; ++j) { const f32x4 a = ((const LAS f32x4*)wt)[(lane >> 4) * 4 + j], b = ((const LAS f32x4*)wt)[16 + (lane >> 4) * 4 + j];
              t0 += (a.x + a.y) + (a.z + a.w); t1 += (b.x + b.y) + (b.z + b.w); }
          exs[lane] = w0 / t0; exs[64 + lane] = w1 / t1; LDS_WAIT(); }
        { const int i0 = exi[lane], i1 = exi[64 + lane]; LAS float* exu = (LAS float*)(slot + 1088); LAS float* exv = (LAS float*)(slot + 1632);
          exu[lane] = p.US[i0]; exu[64 + lane] = p.US[i1]; exv[lane] = p.VS[i0]; exv[64 + lane] = p.VS[i1]; LDS_WAIT(); }
        if (lane == 0) flg[0] = (unsigned)(nt + 1);
    }
    } else {
    int lq = lane >> 2; asm volatile("" : "+v"(lq)); const bool lb0 = (lane & 1) != 0, lb1 = (lane & 2) != 0;
    for (int nt = 0; nt < ntot; ++nt) {
        LAS unsigned char* slot = pb + SLOT0 + (nt & 1) * SLOTSZ;
        while ((int)__builtin_amdgcn_readfirstlane((int)flg[0]) <= nt) __builtin_amdgcn_s_sleep(2);
        asm volatile("" ::: "memory");
        const int idA = ((const LAS int*)slot)[lane], idB = ((const LAS int*)slot)[64 + lane];
        const float gA = ((const LAS float*)(slot + 544))[lane], gB = ((const LAS float*)(slot + 544))[64 + lane];
        const float usA = ((const LAS float*)(slot + 1088))[lane], usB = ((const LAS float*)(slot + 1088))[64 + lane], vsA = ((const LAS float*)(slot + 1632))[lane], vsB = ((const LAS float*)(slot + 1632))[64 + lane];
        const float r2 = *(const LAS float*)(slot + 2176);
        f32x2 mf[16];
#pragma unroll
        for (int q = 0; q < 4; ++q) { const u32x4 w = ((const LAS u32x4*)(slot + 2304))[q * 64 + lane];
            mf[4 * q + 0] = (f32x2){bflo(w.x), bfhi(w.x)}; mf[4 * q + 1] = (f32x2){bflo(w.y), bfhi(w.y)}; mf[4 * q + 2] = (f32x2){bflo(w.z), bfhi(w.z)}; mf[4 * q + 3] = (f32x2){bflo(w.w), bfhi(w.w)}; }
        LDS_WAIT();
        if (lane == 0) flg[1] = (unsigned)(nt + 1);
        unsigned lo16 = (unsigned)lane * 16u; asm volatile("" : "+v"(lo16));
        const __amdgpu_buffer_rsrc_t rsU = __builtin_amdgcn_make_buffer_rsrc((void*)p.U8, (short)0, NEXP * EROW, 0x00020000), rsV = __builtin_amdgcn_make_buffer_rsrc((void*)p.V8, (short)0, NEXP * EROW, 0x00020000);
        u32x4 rb[4][4];
#define ROW_LD(dst, tab, id) do { dst = __builtin_amdgcn_raw_buffer_load_b128((tab), lo16, (unsigned)(id) * (unsigned)EROW, PEER_AUX); } while (0)
#define GRP_LD(buf, tab, idv, i0) do { _Pragma("unroll") for (int x = 0; x < 4; ++x) ROW_LD(rb[buf][x], tab, __builtin_amdgcn_readlane(idv, (i0) + x)); __builtin_amdgcn_sched_barrier(0); } while (0)
#define FP4X2(w, b) __builtin_amdgcn_cvt_scalef32_pk_f32_fp4(w, 1.0f, b)
#define U_PROC(buf, i0) do { float d_[4]; \
            _Pragma("unroll") for (int x = 0; x < 4; ++x) { const u32x4 r_ = rb[buf][x]; f32x2 c0 = {0.f, 0.f}, c1 = {0.f, 0.f}; \
                _Pragma("unroll") for (int d = 0; d < 4; ++d) { c0 = __builtin_elementwise_fma(FP4X2(r_[d], 0), mf[4 * d], c0); c1 = __builtin_elementwise_fma(FP4X2(r_[d], 1), mf[4 * d + 1], c1); \
                    c0 = __builtin_elementwise_fma(FP4X2(r_[d], 2), mf[4 * d + 2], c0); c1 = __builtin_elementwise_fma(FP4X2(r_[d], 3), mf[4 * d + 3], c1); } \
                c0 += c1; d_[x] = c0.x + c0.y; } \
            const float t_ = quad4_total(d_[0], d_[1], d_[2], d_[3], lb0, lb1); h = (lq == ((i0) >> 2)) ? t_ : h; \
            __builtin_amdgcn_sched_barrier(0); } while (0)
#define V_PROC(buf, i0) do { _Pragma("unroll") for (int x = 0; x < 4; ++x) { const float c_ = __builtin_bit_cast(float, __builtin_amdgcn_readlane(__builtin_bit_cast(int, cc), (i0) + x)); \
                const u32x4 r_ = rb[buf][x]; const f32x2 c2 = {c_, c_}; \
                _Pragma("unroll") for (int d = 0; d < 4; ++d) { oacc[4 * d] = __builtin_elementwise_fma(FP4X2(r_[d], 0), c2, oacc[4 * d]); oacc[4 * d + 1] = __builtin_elementwise_fma(FP4X2(r_[d], 1), c2, oacc[4 * d + 1]); \
                    oacc[4 * d + 2] = __builtin_elementwise_fma(FP4X2(r_[d], 2), c2, oacc[4 * d + 2]); oacc[4 * d + 3] = __builtin_elementwise_fma(FP4X2(r_[d], 3), c2, oacc[4 * d + 3]); } } \
            __builtin_amdgcn_sched_barrier(0); } while (0)
        float hv[2];
        if (PMODE != 4) { GRP_LD(0, rsU, idA, 0); }
#pragma unroll
        for (int hf = 0; hf < 2; ++hf) {
            const int idc = hf ? idB : idA, idn = hf ? idA : idB; const __amdgpu_buffer_rsrc_t tn = hf ? rsV : rsU;
            float h = 0.f;
#pragma unroll 1
            for (int gl = 0; gl < (PMODE == 4 ? 0 : 16); gl += 4) {
#pragma unroll
                for (int k = 0; k < 4; ++k) {
                    { const int G = gl + k + 1; const bool nx = G >= 16; const int idv = nx ? idn : idc; const __amdgpu_buffer_rsrc_t tb = nx ? tn : rsU; GRP_LD((k + 1) & 3, tb, idv, (G & 15) * 4); }
                    U_PROC(k, (gl + k) * 4);
                }
            }
            hv[hf] = h;
        }
        const float cA = gA * gelu_erf(hv[0] * r2 * usA) * vsA, cB = gB * gelu_erf(hv[1] * r2 * usB) * vsB;
        f32x2 oacc[16];
#pragma unroll
        for (int j = 0; j < 16; ++j) oacc[j] = (f32x2){0.f, 0.f};
#pragma unroll
        for (int hf = 0; hf < 2; ++hf) {
            const int idc = hf ? idB : idA; const float cc = hf ? cB : cA;
#pragma unroll 1
            for (int gl = 0; gl < (PMODE == 4 ? 0 : 16); gl += 4) {
#pragma unroll
                for (int k = 0; k < 4; ++k) {
                    { const int G = gl + k + 1; const bool nx = G >= 16; if (hf == 0 || !nx) { const int idv = nx ? idB : idc; GRP_LD((k + 1) & 3, rsV, idv, (G & 15) * 4); } }
                    V_PROC(k, (gl + k) * 4);
                }
            }
        }
#undef ROW_LD
#undef GRP_LD
#undef U_PROC
#undef V_PROC
#undef FP4X2
        while (nt - (int)__builtin_amdgcn_readfirstlane((int)flg[3]) >= 2) __builtin_amdgcn_s_sleep(2);
        asm volatile("" ::: "memory");
        { LAS f32x4* ob = (LAS f32x4*)(pb + OB0 + (nt & 1) * OBSZ);
#pragma unroll
          for (int q = 0; q < 8; ++q) ob[q * 64 + lane] = (f32x4){oacc[2 * q].x, oacc[2 * q].y, oacc[2 * q + 1].x, oacc[2 * q + 1].y};
          LDS_WAIT(); }
        if (lane == 0) flg[2] = (unsigned)(nt + 1);
    }
    }
}

#ifndef MK_LAST_PHASE
#define MK_LAST_PHASE 99
#endif

struct KArgs { const float* in[26]; float* out; unsigned char* ws; };
constexpr size_t al256(size_t x) { return (x + 255) & ~(size_t)255; }
#define WS_LIST(X) \
    X(CTL, unsigned, 16384) \
    X(WinT, bf16_t, (size_t)INWP * DM * 2) X(WuqT, bf16_t, 1536 * 512 * 2) X(WukT, bf16_t, 1024 * 512 * 2) X(WuvTg, bf16_t, 1024 * 512 * 2) X(WuvT, bf16_t, 1024 * 512 * 2) X(WukN, bf16_t, 512 * 1024 * 2) \
    X(WoutT, bf16_t, (size_t)DM * DM * 2) X(WsT, bf16_t, (size_t)DM * DM * 2) X(WgT, bf16_t, (size_t)DM * DM * 2) X(WpT, bf16_t, (size_t)DM * PLE * 2) X(U8, unsigned char, (size_t)NEXP * DM) X(V8, unsigned char, (size_t)NEXP * DM) X(US, float, (size_t)NEXP * 4) X(VS, float, (size_t)NEXP * 4) \
    X(tabR, f32x2, (size_t)SEQ * 128 * 8) X(tab64, f32x2, (size_t)SEQ * 32 * 8) X(XN, bf16_t, (size_t)MT * DM * 2) X(Pb, bf16_t, (size_t)MT * PLE * 2) \
    X(RQ, bf16_t, (size_t)MT * RW * 2) X(RK, bf16_t, (size_t)MT * RW * 2) X(RKt, bf16_t, (size_t)MT * RW * 2) X(RVt, bf16_t, (size_t)MT * RW * 2) X(RG, bf16_t, (size_t)MT * RW * 2) \
    X(ZCQ, bf16_t, (size_t)MT * 512 * 2) X(ZCKV, bf16_t, (size_t)MT * 512 * 2) X(KRb, bf16_t, (size_t)MT * 64 * 2) X(CKVNs, bf16_t, (size_t)MS * 512 * 2) \
    X(Q, bf16_t, (size_t)MT * 1536 * 2) X(KN, bf16_t, (size_t)MP * 1024 * 2) X(VTp, bf16_t, (size_t)1024 * MP * 2) X(PP, bf16_t, (size_t)MT * DM * 2) \
    X(CACHE, bf16_t, (size_t)DECB * PAST * CROW * 2) X(S0T, bf16_t, (size_t)128 * 65536 * 2) X(SPREV, bf16_t, (size_t)512 * 65536 * 2) X(ACat, bf16_t, (size_t)MT * DM * 2) X(PARTO, bf16_t, (size_t)2 * MP * MLAW * 2) X(PARTML, f32x2, (size_t)2 * MP * MH * 8) \
    X(ssq1, float, (size_t)MT * 16 * 4) X(OINTRA, float, (size_t)MT * RW * 4) X(KVp, float, (size_t)512 * 65536 * 4) X(H1, float, (size_t)MT * DM * 4) X(ssq2, float, (size_t)MT * 32 * 4) X(ssq3, float, (size_t)MT * 32 * 4)
struct WsOff {
#define X(name, T, bytes) size_t name;
    WS_LIST(X)
#undef X
    size_t total;
};
constexpr WsOff make_wsoff() { WsOff o{}; size_t off = 0;
#define X(name, T, bytes) o.name = off; off += al256(bytes);
    WS_LIST(X)
#undef X
    o.total = off; return o; }
constexpr WsOff WSO = make_wsoff();
__device__ __forceinline__ Prm make_prm(const KArgs& a) { Prm p;
#pragma unroll
    for (int i = 0; i < 26; ++i) p.in[i] = a.in[i];
    p.out = a.out;
#define X(name, T, bytes) p.name = (T*)(a.ws + WSO.name);
    WS_LIST(X)
#undef X
    p.SC = p.KVp; return p; }

__device__ __forceinline__ void dbg_fill(const Prm& p, int last, const XcdBarrier& xb, int tid0) {
    xcd_barrier(xb);
    const long gt = (long)blockIdx.x * NTHR + tid0, NGT = (long)gridDim.x * NTHR;
    for (long i = gt; i < (long)MT * DM; i += NGT) {
        float v = 0.f;
        if (last == 3 || last == 4) v = bf2f(p.ACat[i]);
        else if (last == 5 || last == 7) v = p.H1[i];
        else if (last == 6) v = p.SC[i];
        else if (last == 8) v = p.out[O_Y + i];
        if (!(fabsf(v) < 1e30f)) v = 12345.f;
        p.out[O_Y + i] = v;
    }
    if (last < 3) for (long i = gt; i < 262144 / 4; i += NGT) ((f32x4*)(p.out + O_RETP))[i] = (f32x4){0.f, 0.f, 0.f, 0.f};
}
constexpr int LDS_BYTES = 163840;
__global__ void __launch_bounds__(NTHR, 2) mk_fwd(KArgs ka) {
    extern __shared__ __attribute__((aligned(16))) unsigned char lds_raw[];
    LAS unsigned char* lds = (LAS unsigned char*)lds_raw;
    const Prm p = make_prm(ka);
    volatile LAS unsigned* bst = (volatile LAS unsigned*)(lds + LDS_BYTES - 16);
    int wave_s_ = __builtin_amdgcn_readfirstlane((int)threadIdx.x >> 6); asm volatile("" : "+s"(wave_s_)); const int wave_s = wave_s_;
    if (wave_s == 0 && lane_id() < 4) bst[lane_id()] = 0u;
    __syncthreads();
    const XcdBarrier xbar = xcd_barrier_post(p.CTL, bst, wave_s == 0);
#define GRID_SYNC() xcd_barrier(xbar)
#define PHASE_IDS() int wave = wave_s; asm volatile("" : "+s"(wave)); int tid = wave * 64 + lane_id(); asm volatile("" : "+v"(tid)); const int lane = tid & 63; (void)lane
#ifndef SKIP0
    { PHASE_IDS(); phase0(p, lds, tid, lane, wave); }
#ifdef REP0
    GRID_SYNC(); { PHASE_IDS(); phase0<REP0>(p, lds, tid, lane, wave); }
#endif
#endif
    GRID_SYNC();
#ifndef SKIP1
    { asm volatile("" ::: "memory"); pg8::Gemm g{p.XN, p.WinT, MT, INWP, DM}; pg8::StaticOrder S; S.init(MT, INWP, (int)gridDim.x, (int)blockIdx.x); S.wv = wave_s; EpiZ E{p};
      pg8::gemm_phase<EpiZ, pg8::StaticOrder, true, true>(lds, g, S, E); }
#ifdef REP1
    GRID_SYNC();
    { asm volatile("" ::: "memory"); pg8::Gemm g{p.XN, p.WinT, MT, INWP, DM}; pg8::StaticOrder S; S.init(MT, INWP, (int)gridDim.x, (int)blockIdx.x); S.wv = wave_s; EpiZ E{p};
      pg8::gemm_phase<EpiZ, pg8::StaticOrder, true, true>(lds, g, S, E); }
#endif
#endif
    GRID_SYNC();
#ifndef SKIP2
    { PHASE_IDS(); phase2(p, lds, tid, lane, wave); }
#ifdef REP2
    GRID_SYNC(); { PHASE_IDS(); phase2<REP2>(p, lds, tid, lane, wave); }
#endif
#endif
    if (MK_LAST_PHASE <= 2) { dbg_fill(p, MK_LAST_PHASE, xbar, wave_s * 64 + lane_id()); return; }
    GRID_SYNC();
#ifndef SKIP3
    { PHASE_IDS(); phase3(p, lds, tid, lane, wave); }
#ifdef REP3
    GRID_SYNC(); { PHASE_IDS(); phase3<REP3>(p, lds, tid, lane, wave); }
#endif
#endif
    if (MK_LAST_PHASE <= 3) { dbg_fill(p, MK_LAST_PHASE, xbar, wave_s * 64 + lane_id()); return; }
    GRID_SYNC();
#ifndef SKIP4
    { PHASE_IDS(); phase4(p, lds, tid, lane, wave); }
#endif
    if (MK_LAST_PHASE <= 4) { dbg_fill(p, MK_LAST_PHASE, xbar, wave_s * 64 + lane_id()); return; }
    GRID_SYNC();
    { PHASE_IDS(); phase5a(p, lds, tid, lane, wave); }
    GRID_SYNC();
    { PHASE_IDS(); phase5b(p, lds, tid, lane, wave); }
    GRID_SYNC();
    { PHASE_IDS(); phase6c(p, lds, tid, lane, wave); }
    GRID_SYNC();
#ifdef REP7
    { PHASE_IDS(); phase7<REP7>(p, lds, tid, lane, wave); } GRID_SYNC();
#endif
    { PHASE_IDS(); phase7(p, lds, tid, lane, wave); }
    GRID_SYNC();
    { PHASE_IDS(); phase8a(p, lds, tid, lane, wave); }
    GRID_SYNC();
    { PHASE_IDS(); phase8b(p, lds, tid, lane, wave); }
    GRID_SYNC();
    { PHASE_IDS(); phase9s(p, lds, tid, lane, wave); }
}

extern "C" void kernel_launch(void* const* d_in, const int* in_sizes, int n_in, void* d_out, int out_size, void* d_ws, size_t ws_size, hipStream_t stream) {
    static int grid = 0;
    if (grid == 0) {
        int dev = 0, cus = 0, per_cu = 0;
        hipGetDevice(&dev);
        hipDeviceGetAttribute(&cus, hipDeviceAttributeMultiprocessorCount, dev);
        if (hipFuncSetAttribute((const void*)mk_fwd, hipFuncAttributeMaxDynamicSharedMemorySize, LDS_BYTES) != hipSuccess) { fprintf(stderr, "kernel_launch: hipFuncSetAttribute failed\n"); grid = -1; return; }
        if (hipOccupancyMaxActiveBlocksPerMultiprocessor(&per_cu, (const void*)mk_fwd, NTHR, LDS_BYTES) != hipSuccess || per_cu < 1) { fprintf(stderr, "kernel_launch: occupancy query says %d blocks per CU\n", per_cu); (void)hipGetLastError(); grid = -1; return; }
        grid = cus;
        if (n_in != 26 || out_size != (int)O_TOTAL) { fprintf(stderr, "kernel_launch: unexpected n_in %d / out_size %d\n", n_in, out_size); grid = -1; return; }
    }
    if (grid < 0) return;
    KArgs p{};
    for (int i = 0; i < 26; ++i) p.in[i] = (const float*)d_in[i];
    p.out = (float*)d_out; p.ws = (unsigned char*)d_ws;
    if (WSO.total > ws_size) { fprintf(stderr, "kernel_launch: workspace too small: need %zu, have %zu\n", (size_t)WSO.total, ws_size); return; }
    if (hipMemsetAsync((unsigned char*)d_ws + WSO.CTL, 0, 16384, stream) != hipSuccess) { fprintf(stderr, "kernel_launch: hipMemsetAsync failed\n"); return; }
    hipLaunchKernelGGL(mk_fwd, dim3(grid), dim3(NTHR), LDS_BYTES, stream, p);
    const hipError_t e = hipPeekAtLastError();
    if (e != hipSuccess) fprintf(stderr, "kernel_launch: launch failed: %s (grid %d)\n", hipGetErrorName(e), grid);
}
```

```cpp
#include <hip/hip_runtime.h>
#include <hip/hip_cooperative_groups.h>
#include <cstdio>
#include <cstdint>
namespace cg = cooperative_groups;

constexpr int DM = 2048, SEQ = 8192, DECB = 32, DECS = 32, PAST = 4096;
constexpr int MP = SEQ, MS = DECB * DECS, MT = MP + MS;
constexpr int RH = 4, RDK = 256, RDV = 256, RW = 1024;
constexpr int MH = 8, QL = 512, KVL = 512, NOPE = 128, ROPE = 64, VH = 128, QKH = 192, MLAW = 1024;
constexpr int NKEYS = 128, NEXP = 16384, PH = 8, PTOPK = 16, PLE = 256;
constexpr int INW = 5184, INWP = 5376;
constexpr float EPS = 1e-6f;
constexpr int CROW = 576;
constexpr float QSCALE = 0.07216878364870322f * 1.4426950408889634f;

constexpr size_t O_Y = 0, O_CKVP = 18874368, O_KRP = 23068672, O_RETP = 23592960, O_CKVS = 23855104, O_KRS = 24379392, O_RETS = 24444928, O_TOTAL = 32833536;
namespace pg8 {
#define PG8_LAS __attribute__((address_space(3)))
typedef unsigned short bf16_t;
typedef short bf16x8 __attribute__((ext_vector_type(8)));
typedef float f32x4 __attribute__((ext_vector_type(4)));
typedef unsigned u32x4 __attribute__((ext_vector_type(4)));
constexpr int BM = 256, BK = 64, HALF = 128, HTB = HALF * BK * 2  , STAGE_BYTES = 8 * HTB, NXCD = 8, WGM = 8;

__host__ __device__ __forceinline__ int lds_byte(int r, int c) { const int st = (r >> 4) * 2 + (c >> 5), rr = r & 15, cc = c & 31, ob = rr * 64 + cc * 2; return st * 1024 + (ob ^ (((ob >> 9) & 1) << 5)); }
__host__ __device__ __forceinline__ void stage_rc(int b, int& R, int& C) { const int st = b / 1024, sb = b % 1024, swz = sb ^ (((sb >> 9) & 1) << 5); R = (st >> 1) * 16 + swz / 64; C = (st & 1) * 32 + (swz % 64) / 2; }
__host__ __device__ __forceinline__ int perm32(int rho) { const int n = rho >> 4, i = rho & 15; return 8 * (i >> 2) + 4 * n + (i & 3); }

struct Unit { int pm, pn; };
struct Gemm { const bf16_t* A; const bf16_t* Bt; int M, N, K; };

struct StaticOrder {
    int nM, nN, nwg, G, c, wv = 0;
    __host__ __device__ void init(int M, int N, int G_, int c_) { nM = M / BM; nN = N / BM; nwg = nM * nN; G = G_; c = c_; }
    __host__ __device__ bool next(int i, Unit& u) const {
        const long L = (long)i * G + c; if (L >= nwg) return false;
        int wgid = (int)L; { const int q = nwg / NXCD, r = nwg % NXCD, xcd = wgid % NXCD, off = wgid / NXCD; wgid = (xcd < r ? xcd * (q + 1) : r * (q + 1) + (xcd - r) * q) + off; }
        const int nig = WGM * nN, gid = wgid / nig, fm = gid * WGM, gsz = (nM - fm) < WGM ? (nM - fm) : WGM;
        u.pm = fm + ((wgid % nig) % gsz); u.pn = (wgid % nig) / gsz; return true;
    }
    __device__ __forceinline__ void a_ready(const Unit&) const {}
    __device__ __forceinline__ void done(const Unit&) const {}
};

__device__ __forceinline__ unsigned cvt_pk_bf16(float lo, float hi) { unsigned r; asm volatile("v_cvt_pk_bf16_f32 %0, %1, %2" : "=v"(r) : "v"(lo), "v"(hi)); return r; }
typedef float f32x2 __attribute__((ext_vector_type(2)));
__device__ __forceinline__ f32x2 gelu_pk(f32x2 v) {
    const f32x2 av = __builtin_elementwise_abs(v), d = av * 0.2316418882f + 1.0f;
    f32x2 t; t.x = __builtin_amdgcn_rcpf(d.x); t.y = __builtin_amdgcn_rcpf(d.y);
    f32x2 q = t * 0.5307027145f + (-0.7265760135f); q = q * t + 0.7107068705f; q = q * t + (-0.142248368f); q = q * t + 0.127414796f; q = q * t;
    const f32x2 s = (v * v) * (-0.72134752044f);
    f32x2 e; e.x = __builtin_amdgcn_exp2f(s.x); e.y = __builtin_amdgcn_exp2f(s.y);
    const f32x2 m = v * (q * e), r = v - m;
    f32x2 o; o.x = v.x < 0.f ? m.x : r.x; o.y = v.y < 0.f ? m.y : r.y; return o;
}

template <int ACT  > struct EpiBf16 {
    static constexpr bool PERM = true, AFTER_DRAIN = false; static_assert(ACT == 0 || ACT == 1, "EpiBf16: ACT is 0 (none) or 1 (gelu_pk)");
    bf16_t* O; int ldc; const float* bias; int split_cols; size_t split_stride; float scale0;
    __device__ __forceinline__ void operator()(const f32x4 (&acc)[2][2][4][2], const Unit& u, int wr, int wc, int fr, int fq) const {
        const int row0 = u.pm * BM + wr * 64 + fr; int colt = u.pn * BM; bf16_t* base = O;
        float sc = 1.f; if (split_cols) { const int t = colt / split_cols; base += (size_t)t * split_stride; colt -= t * split_cols; if (t == 0) sc = scale0; }
        const int col0 = colt + wc * 32 + 8 * fq, bcol0 = u.pn * BM + wc * 32 + 8 * fq;
        f32x4 bv[2][2];
#pragma unroll
        for (int bj = 0; bj < 2; ++bj)
#pragma unroll
            for (int n = 0; n < 2; ++n) bv[bj][n] = bias ? *(const f32x4*)(bias + bcol0 + bj * HALF + 4 * n) : (f32x4){0.f, 0.f, 0.f, 0.f};
#pragma unroll
        for (int ai = 0; ai < 2; ++ai)
#pragma unroll
            for (int m = 0; m < 4; ++m) { bf16_t* rowp = base + (size_t)(row0 + ai * HALF + m * 16) * ldc + col0;
#pragma unroll
                for (int bj = 0; bj < 2; ++bj) { f32x4 v0 = acc[ai][bj][m][0] + bv[bj][0], v1 = acc[ai][bj][m][1] + bv[bj][1];
                    if (ACT == 1) { f32x2 a = gelu_pk((f32x2){v0[0], v0[1]}), b = gelu_pk((f32x2){v0[2], v0[3]}), c = gelu_pk((f32x2){v1[0], v1[1]}), d = gelu_pk((f32x2){v1[2], v1[3]});
                        v0 = (f32x4){a.x, a.y, b.x, b.y}; v1 = (f32x4){c.x, c.y, d.x, d.y}; }
                    v0 = v0 * sc; v1 = v1 * sc; u32x4 w; w.x = cvt_pk_bf16(v0[0], v0[1]); w.y = cvt_pk_bf16(v0[2], v0[3]); w.z = cvt_pk_bf16(v1[0], v1[1]); w.w = cvt_pk_bf16(v1[2], v1[3]);
                    *(u32x4*)(rowp + bj * HALF) = w; } }
    }
};
template <class Epi, class Sched, bool ALIGN_EPI = false, bool SP2 = false, bool HALFM = false>
__device__ __forceinline__ void gemm_phase(PG8_LAS unsigned char* lds, const Gemm g, const Sched& S, const Epi& E) {
    int lane_l; asm volatile("v_mbcnt_lo_u32_b32 %0, -1, 0\n\tv_mbcnt_hi_u32_b32 %0, -1, %0" : "=v"(lane_l)); int tid_l = S.wv * 64 + lane_l; asm volatile("" : "+v"(tid_l));
    const int tid = tid_l, wid = __builtin_amdgcn_readfirstlane(tid >> 6), lane = tid & 63, wr = wid >> 2, wc = wid & 3, fr = lane & 15, fq = lane >> 4;
    const int K = g.K, nt = K / BK;
    unsigned voffA[2], voffB[2];
#pragma unroll
    for (int i = 0; i < 2; ++i) { int R, C; stage_rc(tid * 16 + i * 8192, R, C); const int Rb = Epi::PERM ? ((R & ~31) + perm32(R & 31)) : R;
        voffA[i] = (unsigned)(R * K + C) * 2u; voffB[i] = (unsigned)(Rb * K + C) * 2u; }
    const size_t kstep = (size_t)(BK * 2);
    const size_t hstep = (size_t)HALF * K * 2;
    const size_t tstep = 2 * hstep;
    const size_t hstepA = HALFM ? 0 : hstep, ustepA = HALFM ? hstep : tstep;
    const unsigned ldsw = (unsigned)wid * 1024u;
    const int aoff = lds_byte(wr * 64 + fr, fq * 8), boff = lds_byte(wc * 32 + fr, fq * 8);
#define PG8_SA(b, h) (((b) * 2 + (h)) * HTB)
#define PG8_SB(b, h) ((4 + (b) * 2 + (h)) * HTB)
#define PG8_STAGE(bufoff, gbase, voff) do { _Pragma("unroll") for (int _i = 0; _i < 2; ++_i) \
        __builtin_amdgcn_global_load_lds((const unsigned*)((const char*)(gbase) + (voff)[_i]), (PG8_LAS unsigned*)(lds + (bufoff) + ldsw + _i * 8192), 16, 0, 0); } while (0)
#define PG8_LDA(dst, b, h) do { _Pragma("unroll") for (int m = 0; m < 4; ++m) _Pragma("unroll") for (int k = 0; k < 2; ++k) dst[m][k] = *(const PG8_LAS bf16x8*)(lds + PG8_SA(b, h) + aoff + m * 2048 + k * 1024); } while (0)
#define PG8_LDB(dst, b, h) do { _Pragma("unroll") for (int n = 0; n < 2; ++n) _Pragma("unroll") for (int k = 0; k < 2; ++k) dst[n][k] = *(const PG8_LAS bf16x8*)(lds + PG8_SB(b, h) + boff + n * 2048 + k * 1024); } while (0)
#define PG8_MMA(ai, bj, At, Bt) do { __builtin_amdgcn_s_setprio(1); _Pragma("unroll") for (int m = 0; m < 4; ++m) _Pragma("unroll") for (int n = 0; n < 2; ++n) _Pragma("unroll") for (int k = 0; k < 2; ++k) \
        acc[ai][bj][m][n] = __builtin_amdgcn_mfma_f32_16x16x32_bf16(Bt[n][k], At[m][k], acc[ai][bj][m][n], 0, 0, 0); __builtin_amdgcn_s_setprio(0); } while (0)
#define PG8_WAIT_V(n) asm volatile("s_waitcnt vmcnt(" #n ")" ::: "memory")
#define PG8_WAIT_L(n) asm volatile("s_waitcnt lgkmcnt(" #n ")" ::: "memory")
#define PG8_BAR __builtin_amdgcn_s_barrier()
#define PG8_SCHED __builtin_amdgcn_sched_barrier(0)
    Unit cur, nxt; int ui = 0;
    if (!S.next(0, cur)) return;
    f32x4 acc[2][2][4][2];
#pragma unroll
    for (int a = 0; a < 2; ++a)
#pragma unroll
        for (int b = 0; b < 2; ++b)
#pragma unroll
            for (int m = 0; m < 4; ++m)
#pragma unroll
                for (int n = 0; n < 2; ++n) acc[a][b][m][n] = (f32x4){0.f, 0.f, 0.f, 0.f};
    bf16x8 At[4][2], B0[2][2], B1[2][2];
    const char* cA = (const char*)g.A + (size_t)cur.pm * ustepA; const char* cB = (const char*)g.Bt + (size_t)cur.pn * tstep;
    S.a_ready(cur);
    if constexpr (SP2) {
        PG8_STAGE(PG8_SB(0, 0), cB, voffB); PG8_STAGE(PG8_SB(0, 1), cB + hstep, voffB); PG8_STAGE(PG8_SA(0, 0), cA, voffA); PG8_STAGE(PG8_SA(0, 1), cA + hstepA, voffA);
        if (wr == 1) PG8_BAR;
        PG8_WAIT_V(2); PG8_BAR;
        PG8_STAGE(PG8_SB(1, 0), cB + kstep, voffB); PG8_STAGE(PG8_SA(1, 0), cA + kstep, voffA); PG8_STAGE(PG8_SB(1, 1), cB + hstep + kstep, voffB);
        PG8_WAIT_V(6); PG8_BAR;
    } else {
        PG8_STAGE(PG8_SB(0, 0), cB, voffB); PG8_STAGE(PG8_SA(0, 0), cA, voffA); PG8_STAGE(PG8_SB(0, 1), cB + hstep, voffB); PG8_STAGE(PG8_SA(0, 1), cA + hstepA, voffA);
        if (wr == 1) PG8_BAR;
        PG8_WAIT_V(4); PG8_BAR;
        PG8_STAGE(PG8_SB(1, 0), cB + kstep, voffB); PG8_STAGE(PG8_SA(1, 0), cA + kstep, voffA); PG8_STAGE(PG8_SB(1, 1), cB + hstep + kstep, voffB);
        PG8_WAIT_V(6); PG8_BAR;
    }
    for (;;) {
        const bool has_next = S.next(ui + 1, nxt);
        const char* nA = has_next ? (const char*)g.A + (size_t)nxt.pm * ustepA : cA; const char* nB = has_next ? (const char*)g.Bt + (size_t)nxt.pn * tstep : cB;
        for (int t = 0; t < nt; t += 2) {
            const bool last = (t == nt - 2);
            const char* a1 = cA + (size_t)(t + 1) * kstep;
            const char* a2 = last ? nA : cA + (size_t)(t + 2) * kstep; const char* b2 = last ? nB : cB + (size_t)(t + 2) * kstep;
            const char* a3 = a2 + kstep; const char* b3 = b2 + kstep;
            if (last && has_next) S.a_ready(nxt);
            if constexpr (SP2) {
            PG8_LDB(B0, 0, 0); PG8_LDB(B1, 0, 1); PG8_SCHED; PG8_LDA(At, 0, 0); PG8_STAGE(PG8_SA(1, 1), a1 + hstepA, voffA);
            PG8_WAIT_V(8); PG8_WAIT_L(0); PG8_BAR; PG8_MMA(0, 0, At, B0); PG8_MMA(0, 1, At, B1); PG8_BAR; PG8_SCHED;
            PG8_LDA(At, 0, 1); PG8_STAGE(PG8_SB(0, 0), b2, voffB); PG8_STAGE(PG8_SB(0, 1), b2 + hstep, voffB); PG8_STAGE(PG8_SA(0, 0), a2, voffA);
            PG8_WAIT_V(8); PG8_WAIT_L(0); PG8_BAR; if constexpr (!HALFM) { PG8_MMA(1, 0, At, B0); PG8_MMA(1, 1, At, B1); } PG8_BAR; PG8_SCHED;
            PG8_LDB(B0, 1, 0); PG8_LDB(B1, 1, 1); PG8_SCHED; PG8_LDA(At, 1, 0); PG8_STAGE(PG8_SA(0, 1), a2 + hstepA, voffA);
            PG8_WAIT_V(8); PG8_WAIT_L(0); PG8_BAR; PG8_MMA(0, 0, At, B0); PG8_MMA(0, 1, At, B1); PG8_BAR; PG8_SCHED;
            PG8_LDA(At, 1, 1); PG8_STAGE(PG8_SB(1, 0), b3, voffB); PG8_STAGE(PG8_SB(1, 1), b3 + hstep, voffB); PG8_STAGE(PG8_SA(1, 0), a3, voffA);
            PG8_WAIT_V(8); PG8_WAIT_L(0); PG8_BAR; if constexpr (!HALFM) { PG8_MMA(1, 0, At, B0); PG8_MMA(1, 1, At, B1); } PG8_BAR; PG8_SCHED;
            } else {
            PG8_LDB(B0, 0, 0); PG8_SCHED; PG8_LDA(At, 0, 0); PG8_STAGE(PG8_SA(1, 1), a1 + hstepA, voffA);
            PG8_WAIT_L(8); PG8_BAR; PG8_WAIT_L(0); PG8_MMA(0, 0, At, B0); PG8_BAR; PG8_SCHED;
            PG8_LDB(B1, 0, 1); PG8_STAGE(PG8_SB(0, 0), b2, voffB);
            PG8_BAR; PG8_WAIT_L(0); PG8_MMA(0, 1, At, B1); PG8_BAR;
            PG8_LDA(At, 0, 1); PG8_STAGE(PG8_SA(0, 0), a2, voffA);
            PG8_BAR; PG8_WAIT_L(0); PG8_MMA(1, 0, At, B0); PG8_BAR; PG8_SCHED;
            PG8_STAGE(PG8_SB(0, 1), b2 + hstep, voffB);
            PG8_WAIT_V(6); PG8_BAR; PG8_MMA(1, 1, At, B1); PG8_BAR;
            PG8_LDB(B0, 1, 0); PG8_SCHED; PG8_LDA(At, 1, 0); PG8_STAGE(PG8_SA(0, 1), a2 + hstepA, voffA);
            PG8_WAIT_L(8); PG8_BAR; PG8_WAIT_L(0); PG8_MMA(0, 0, At, B0); PG8_BAR; PG8_SCHED;
            PG8_LDB(B1, 1, 1); PG8_STAGE(PG8_SB(1, 0), b3, voffB);
            PG8_BAR; PG8_WAIT_L(0); PG8_MMA(0, 1, At, B1); PG8_BAR;
            PG8_LDA(At, 1, 1); PG8_STAGE(PG8_SA(1, 0), a3, voffA);
            PG8_BAR; PG8_WAIT_L(0); PG8_MMA(1, 0, At, B0); PG8_BAR; PG8_SCHED;
            PG8_STAGE(PG8_SB(1, 1), b3 + hstep, voffB);
            PG8_WAIT_V(6); PG8_BAR; PG8_MMA(1, 1, At, B1); PG8_BAR;
            }
        }
        if constexpr (ALIGN_EPI) { if (wr == 0) PG8_BAR; }
        if constexpr (!Epi::AFTER_DRAIN) { E(acc, cur, wr, wc, fr, fq); S.done(cur); }
        if (!has_next) break;
#pragma unroll
        for (int a = 0; a < 2; ++a)
#pragma unroll
            for (int b = 0; b < 2; ++b)
#pragma unroll
                for (int m = 0; m < 4; ++m)
#pragma unroll
                    for (int n = 0; n < 2; ++n) acc[a][b][m][n] = (f32x4){0.f, 0.f, 0.f, 0.f};
        cur = nxt; cA = nA; cB = nB; ++ui;
        if constexpr (ALIGN_EPI) { if (wr == 1) PG8_BAR; }
    }
    PG8_WAIT_V(0);
    if constexpr (!ALIGN_EPI) { if (wr == 0) PG8_BAR; }
    PG8_BAR;
    if constexpr (Epi::AFTER_DRAIN) { E.fused(acc, cur, wr, wc, fr, fq, lds, wid, lane); S.done(cur); }
#undef PG8_SA
#undef PG8_SB
#undef PG8_STAGE
#undef PG8_LDA
#undef PG8_LDB
#undef PG8_MMA
#undef PG8_WAIT_V
#undef PG8_WAIT_L
#undef PG8_BAR
#undef PG8_SCHED
}
}

#define LAS __attribute__((address_space(3)))
typedef unsigned short bf16_t;
typedef short bf16x8 __attribute__((ext_vector_type(8)));
typedef short s16x4 __attribute__((ext_vector_type(4)));
typedef float f32x4 __attribute__((ext_vector_type(4)));
typedef float f32x2 __attribute__((ext_vector_type(2)));
typedef unsigned u32x4 __attribute__((ext_vector_type(4)));
typedef unsigned u32x2 __attribute__((ext_vector_type(2)));
#define LDS_WAIT() asm volatile("s_waitcnt lgkmcnt(0)" ::: "memory")
#define VM_WAIT() asm volatile("s_waitcnt vmcnt(0)" ::: "memory")
constexpr int NWAVES = 8, NTHR = 512;
__device__ __forceinline__ int lane_id() { int l; asm volatile("v_mbcnt_lo_u32_b32 %0, -1, 0\n\tv_mbcnt_hi_u32_b32 %0, -1, %0" : "=v"(l)); return l; }

typedef __bf16 bf16x2_t __attribute__((ext_vector_type(2)));
__device__ __forceinline__ unsigned pk2(float lo, float hi) { const f32x2 v = {lo, hi}; return __builtin_bit_cast(unsigned, __builtin_convertvector(v, bf16x2_t)); }
__device__ __forceinline__ bf16_t f2bf(float f) { return (bf16_t)(pk2(f, 0.f) & 0xffffu); }
__device__ __forceinline__ float bf2f(unsigned h) { return __uint_as_float(h << 16); }
__device__ __forceinline__ float bflo(unsigned w) { return __uint_as_float(w << 16); }
__device__ __forceinline__ float bfhi(unsigned w) { return __uint_as_float(w & 0xffff0000u); }
template <int CTRL> __device__ __forceinline__ float dppf(float v) { return __builtin_bit_cast(float, __builtin_amdgcn_update_dpp(0, __builtin_bit_cast(int, v), CTRL, 0xf, 0xf, true)); }
__device__ __forceinline__ float wave_sum(float v) {
    v += dppf<0xB1>(v); v += dppf<0x4E>(v); v += dppf<0x141>(v); v += dppf<0x140>(v);
    const float s0 = __builtin_bit_cast(float, __builtin_amdgcn_readlane(__builtin_bit_cast(int, v), 0)), s1 = __builtin_bit_cast(float, __builtin_amdgcn_readlane(__builtin_bit_cast(int, v), 16));
    const float s2 = __builtin_bit_cast(float, __builtin_amdgcn_readlane(__builtin_bit_cast(int, v), 32)), s3 = __builtin_bit_cast(float, __builtin_amdgcn_readlane(__builtin_bit_cast(int, v), 48));
    return (s0 + s1) + (s2 + s3);
}
__device__ __forceinline__ float quad4_total(float d0, float d1, float d2, float d3, bool b0, bool b1) {
    const float v01 = (b0 ? d1 : d0) + dppf<0xB1>(b0 ? d0 : d1), v23 = (b0 ? d3 : d2) + dppf<0xB1>(b0 ? d2 : d3);
    float v = (b1 ? v23 : v01) + dppf<0x4E>(b1 ? v01 : v23);
    v += dppf<0x124>(v); v += dppf<0x128>(v);
    { const auto r = __builtin_amdgcn_permlane16_swap(__builtin_bit_cast(unsigned, v), __builtin_bit_cast(unsigned, v), false, false); v = __builtin_bit_cast(float, (unsigned)r[0]) + __builtin_bit_cast(float, (unsigned)r[1]); }
    { const auto r = __builtin_amdgcn_permlane32_swap(__builtin_bit_cast(unsigned, v), __builtin_bit_cast(unsigned, v), false, false); v = __builtin_bit_cast(float, (unsigned)r[0]) + __builtin_bit_cast(float, (unsigned)r[1]); }
    return v;
}
__device__ __forceinline__ float wave_max(float v) {
#pragma unroll
    for (int o = 1; o < 64; o <<= 1) v = fmaxf(v, __shfl_xor(v, o));
    return v;
}
__device__ __forceinline__ f32x4 mfma16(bf16x8 a, bf16x8 b, f32x4 c) { return __builtin_amdgcn_mfma_f32_16x16x32_bf16(a, b, c, 0, 0, 0); }
__device__ __forceinline__ bf16x8 pack8(f32x4 a, f32x4 b) {
    u32x4 w; w.x = pk2(a[0], a[1]); w.y = pk2(a[2], a[3]); w.z = pk2(b[0], b[1]); w.w = pk2(b[2], b[3]);
    return __builtin_bit_cast(bf16x8, w);
}
__device__ __forceinline__ bf16x8 cvt8(const float* p) {
    const f32x4 a = *(const f32x4*)p, b = *(const f32x4*)(p + 4);
    return pack8(a, b);
}
__device__ __forceinline__ float lg2gamma(int h) { return h == 0 ? -0.04580368961312479f : h == 1 ? -0.01800355292833101f : h == 2 ? -0.007117849617096998f : -0.002820519062378663f; }

struct Prm {
    const float* in[26];
    float* out;
    unsigned* CTL;
    bf16_t *WinT, *WuqT, *WukT, *WuvTg, *WuvT, *WukN, *WoutT, *WsT, *WgT, *WpT; unsigned char *U8, *V8; float *US, *VS;
    f32x2 *tabR, *tab64;
    bf16_t *XN, *Pb, *RQ, *RK, *RKt, *RVt, *RG, *ZCQ, *ZCKV, *KRb, *CKVNs, *Q, *KN, *VTp, *PP, *CACHE, *S0T, *SPREV, *ACat, *PARTO; f32x2* PARTML;
    float *ssq1, *OINTRA, *KVp, *H1, *ssq2, *SC, *ssq3;
};
__device__ __forceinline__ const float* xrow(const Prm& p, int row) { return row < MP ? p.in[0] + (size_t)row * DM : p.in[1] + (size_t)(row - MP) * DM; }
__device__ __forceinline__ int rowpos(int row) { return row < MP ? row : PAST + ((row - MP) & 31); }
#define XB_TMO      128
#define XB_XCNT(j)  (256  + 64 * (j))
#define XB_XSUB(j)  (1280 + 64 * (j))
#define XB_XGEN(j)  (2304 + 64 * (j))
#define XB_TOP      3328
#define XB_TOPGEN   3392
#define XCD_BAR_WORDS 3456
#define XB_SPIN_CAP (1u << 18)

__device__ __forceinline__ unsigned xb_ld(unsigned* p)              { return __hip_atomic_load(p, __ATOMIC_RELAXED, __HIP_MEMORY_SCOPE_AGENT); }
__device__ __forceinline__ unsigned xb_add(unsigned* p, unsigned v) { return __hip_atomic_fetch_add(p, v, __ATOMIC_RELAXED, __HIP_MEMORY_SCOPE_AGENT); }
__device__ __forceinline__ unsigned xb_xcc_id() { return (unsigned)__builtin_amdgcn_s_getreg((3 << 11) | 20) & 0xFu; }
#define XB_SPIN(cond, bar) do { unsigned _sp = 0; while (cond) { __builtin_amdgcn_s_sleep(1); \
    if ((++_sp & 255u) == 0u) { if (xb_ld(&(bar)[XB_TMO])) break; if (_sp > XB_SPIN_CAP) { atomicAdd(&(bar)[XB_TMO], 1u); break; } } } } while (0)

__device__ __forceinline__ int xb_lane() { int l; asm volatile("v_mbcnt_lo_u32_b32 %0, -1, 0\n\tv_mbcnt_hi_u32_b32 %0, -1, %0" : "=v"(l)); return l; }
struct XcdBarrier {
    unsigned* bar; unsigned x;
    volatile LAS unsigned* st; bool w0;
};

__device__ __forceinline__ XcdBarrier xcd_barrier_post(unsigned* bar, volatile LAS unsigned* st, bool w0) {
    XcdBarrier b; b.bar = bar; b.x = xb_xcc_id(); b.st = st; b.w0 = w0;
    if (w0 && xb_lane() == 0) (void)xb_add(&bar[XB_XCNT(b.x)], 1u);
    return b;
}
__device__ __forceinline__ void xcd_barrier_complete(unsigned* bar, unsigned x, unsigned& nloc, unsigned& nx) {
    const unsigned G = gridDim.x * gridDim.y * gridDim.z;
    unsigned sum, cnt, mine, sp = 0u;
    for (;;) {
        sum = 0u; cnt = 0u; mine = 0u;
#pragma unroll
        for (unsigned j = 0; j < 16; ++j) { const unsigned c = xb_ld(&bar[XB_XCNT(j)]); sum += c; cnt += (c > 0u) ? 1u : 0u; mine = (j == x) ? c : mine; }
        if (sum == G) break;
        __builtin_amdgcn_s_sleep(1);
        if ((++sp & 255u) == 0u) { if (xb_ld(&bar[XB_TMO])) break; if (sp > XB_SPIN_CAP) { atomicAdd(&bar[XB_TMO], 1u); break; } }
    }
    nloc = mine > 0u ? mine : 1u; nx = cnt > 0u ? cnt : 1u;
}

__device__ __forceinline__ void xcd_barrier(const XcdBarrier& b) {
    asm volatile("s_waitcnt vmcnt(0)" ::: "memory");
    __syncthreads();
    if (b.w0 && xb_lane() == 0) {
        unsigned* bar = b.bar;
        __builtin_amdgcn_s_waitcnt(0);
        unsigned nloc = b.st[0], nx = b.st[1];
        if (nloc == 0u) { xcd_barrier_complete(bar, b.x, nloc, nx); b.st[0] = nloc; b.st[1] = nx; }
        const unsigned old = xb_add(&bar[XB_XSUB(b.x)], 1u);
        const unsigned gen = old / nloc;
        if (old + 1u == (gen + 1u) * nloc) {
            __builtin_amdgcn_fence(__ATOMIC_RELEASE, "agent");
            asm volatile("s_waitcnt vmcnt(0)" ::: "memory");
            const unsigned og = xb_add(&bar[XB_TOP], 1u);
            const unsigned tg = og / nx;
            if (og + 1u == (tg + 1u) * nx) xb_add(&bar[XB_TOPGEN], 1u);
            else XB_SPIN(xb_ld(&bar[XB_TOPGEN]) == tg, bar);
            __builtin_amdgcn_fence(__ATOMIC_ACQUIRE, "agent");
            xb_add(&bar[XB_XGEN(b.x)], 1u);
            asm volatile("s_waitcnt vmcnt(0)" ::: "memory");
        } else {
            XB_SPIN(xb_ld(&bar[XB_XGEN(b.x)]) == gen, bar);
            __builtin_amdgcn_fence(__ATOMIC_ACQUIRE, "agent");
            asm volatile("s_waitcnt vmcnt(0)" ::: "memory");
        }
    }
    __syncthreads();
}

__device__ __forceinline__ void tr_item(const float* __restrict__ W, size_t ldw, int k0, int n0, bf16_t* WT, size_t ldt, int drow0, int dcol0, const float* kscale, LAS float* scr, int lane) {
#pragma unroll 8
    for (int i = 0; i < 32; ++i) { const int kk = 2 * i + (lane >> 5); float v = W[(size_t)(k0 + kk) * ldw + n0 + (lane & 31)]; if (kscale) v *= kscale[k0 + kk]; scr[kk * 33 + (lane & 31)] = v; }
    LDS_WAIT(); asm volatile("" ::: "memory");
    const int c = lane & 7;
#pragma unroll
    for (int j = 0; j < 4; ++j) { const int n = (lane >> 3) + 8 * j; const LAS float* s = scr + (8 * c) * 33 + n;
        u32x4 o; o.x = pk2(s[0 * 33], s[1 * 33]); o.y = pk2(s[2 * 33], s[3 * 33]); o.z = pk2(s[4 * 33], s[5 * 33]); o.w = pk2(s[6 * 33], s[7 * 33]);
        *(u32x4*)(WT + (size_t)(drow0 + n) * ldt + dcol0 + 8 * c) = o; }
    LDS_WAIT(); asm volatile("" ::: "memory");
}
__device__ __forceinline__ void cvt8_store(const float* src, bf16_t* dst) {
    const f32x4 a = *(const f32x4*)src, b = *(const f32x4*)(src + 4);
    u32x4 w; w.x = pk2(a[0], a[1]); w.y = pk2(a[2], a[3]); w.z = pk2(b[0], b[1]); w.w = pk2(b[2], b[3]);
    *(u32x4*)dst = w;
}
typedef float f32x16 __attribute__((ext_vector_type(16)));
typedef float f32x32 __attribute__((ext_vector_type(32)));
typedef unsigned u32x6 __attribute__((ext_vector_type(6)));
constexpr int EROW = 1024;
__device__ __forceinline__ void expert_tables_fp8(const Prm& p, int gw, int NGW, int lane) {
    for (int row = gw; row < 2 * NEXP; row += NGW) {
        const bool isv = row >= NEXP; const int r = row & (NEXP - 1);
        const float* src = (isv ? p.in[21] : p.in[20]) + (size_t)r * DM + lane * 32;
        f32x4 v[8]; float mx = 0.f;
#pragma unroll
        for (int q = 0; q < 8; ++q) { v[q] = *(const f32x4*)(src + q * 4); const f32x4 a = v[q];
            mx = fmaxf(mx, fmaxf(fmaxf(fabsf(a.x), fabsf(a.y)), fmaxf(fabsf(a.z), fabsf(a.w)))); }
        mx = wave_max(mx);
        const float inv = mx > 0.f ? 6.0f / mx : 0.f;
        u32x4 pk;
#pragma unroll
        for (int d = 0; d < 4; ++d) { unsigned w = 0u;
            w = __builtin_amdgcn_cvt_scalef32_pk_fp4_f32(w, v[2 * d][0] * inv, v[2 * d][1] * inv, 1.0f, 0);
            w = __builtin_amdgcn_cvt_scalef32_pk_fp4_f32(w, v[2 * d][2] * inv, v[2 * d][3] * inv, 1.0f, 1);
            w = __builtin_amdgcn_cvt_scalef32_pk_fp4_f32(w, v[2 * d + 1][0] * inv, v[2 * d + 1][1] * inv, 1.0f, 2);
            w = __builtin_amdgcn_cvt_scalef32_pk_fp4_f32(w, v[2 * d + 1][2] * inv, v[2 * d + 1][3] * inv, 1.0f, 3);
            pk[d] = w; }
        *(u32x4*)((isv ? p.V8 : p.U8) + (size_t)r * EROW + lane * 16) = pk;
        if (lane == 0) (isv ? p.VS : p.US)[r] = mx * (1.f / 6.0f);
    }
}
template <int M0 = 255> __device__ __forceinline__ void phase0(const Prm& p, LAS unsigned char* lds, int tid, int lane, int wave) {
    LAS float* scr = (LAS float*)(lds + wave * 8704);
    const int gw = blockIdx.x * NWAVES + wave, NGW = gridDim.x * NWAVES;
    const long gt = (long)blockIdx.x * NTHR + tid, NGT = (long)gridDim.x * NTHR;
    constexpr int I_IN = 32 * 162, I_UQ = 8 * 48, I_UK = 8 * 32, I_OUT = 32 * 64, I_PROJ = 4 * 64, I_S0 = 128 * 32;
    constexpr int NIT = I_IN + I_UQ + 3 * I_UK + 2 * I_OUT + I_PROJ + I_S0;
    if (M0 & 1) for (int it = gw; it < NIT; it += NGW) {
        int r = it;
        if (r < I_IN) { const int kb = r / 162, nb = r % 162, n0 = nb * 32; int drow = n0; if (n0 >= 5120) drow = (n0 == 5120) ? 5120 : 5120 + 128;
            tr_item(p.in[8], INW, kb * 64, n0, p.WinT, DM, drow, kb * 64, nullptr, scr, lane); continue; } r -= I_IN;
        if (r < I_UQ) { const int kb = r / 48, nb = r % 48, n0 = nb * 32, h = n0 / 192, d = n0 % 192; int drow;
            if (d < 128) drow = h * 128 + d; else drow = 1024 + (h >> 2) * 256 + (d >= 160 ? 128 : 0) + (h & 3) * 32;
            tr_item(p.in[10], 1536, kb * 64, n0, p.WuqT, QL, drow, kb * 64, p.in[9], scr, lane); continue; } r -= I_UQ;
        if (r < I_UK) { const int kb = r / 32, nb = r % 32; tr_item(p.in[12], 1024, kb * 64, nb * 32, p.WukT, KVL, nb * 32, kb * 64, p.in[11], scr, lane); continue; } r -= I_UK;
        if (r < I_UK) { const int kb = r / 32, nb = r % 32; tr_item(p.in[13], 1024, kb * 64, nb * 32, p.WuvTg, KVL, nb * 32, kb * 64, p.in[11], scr, lane); continue; } r -= I_UK;
        if (r < I_UK) { const int kb = r / 32, nb = r % 32; tr_item(p.in[13], 1024, kb * 64, nb * 32, p.WuvT, KVL, nb * 32, kb * 64, nullptr, scr, lane); continue; } r -= I_UK;
        if (r < I_OUT) { const int kb = r / 64, nb = r % 64; tr_item(p.in[16], DM, kb * 64, nb * 32, p.WoutT, DM, nb * 32, kb * 64, nullptr, scr, lane); continue; } r -= I_OUT;
        if (r < I_OUT) { const int kb = r / 64, nb = r % 64; tr_item(p.in[23], DM, kb * 64, nb * 32, p.WgT, DM, nb * 32, kb * 64, nullptr, scr, lane); continue; } r -= I_OUT;
        if (r < I_PROJ) { const int kb = r / 64, nb = r % 64; tr_item(p.in[24], DM, kb * 64, nb * 32, p.WpT, PLE, nb * 32, kb * 64, nullptr, scr, lane); continue; } r -= I_PROJ;
        { const int mat = r / 32, q = r % 32, kb = q / 8, nb = q % 8;
          tr_item(p.in[4] + (size_t)mat * 65536, 256, kb * 64, nb * 32, p.S0T + (size_t)mat * 65536, 256, nb * 32, kb * 64, nullptr, scr, lane); }
    }
    if (M0 & 2) for (int it = gw; it < 16 * 128; it += NGW) {
        const int g = it >> 7, k0 = (it & 127) * 16, fr = lane & 15, fq = lane >> 4;
        const float* wq = p.in[18] + (size_t)(k0 + fr) * DM + g * 128 + 8 * fq;
        bf16x8 yf[4];
#pragma unroll
        for (int ds = 0; ds < 4; ++ds) yf[ds] = cvt8(wq + 32 * ds);
        const float* sk = p.in[19] + (size_t)g * 16384 + (size_t)fr * 128 + 8 * fq;
        for (int kb = 0; kb < 8; ++kb) {
            f32x4 acc = {0.f, 0.f, 0.f, 0.f};
#pragma unroll
            for (int ds = 0; ds < 4; ++ds) acc = mfma16(cvt8(sk + (size_t)kb * 2048 + 32 * ds), yf[ds], acc);
#pragma unroll
            for (int rg = 0; rg < 4; ++rg) p.WsT[(size_t)(g * 128 + 16 * kb + 4 * fq + rg) * DM + k0 + fr] = f2bf(acc[rg]);
        }
    }
    for (long i = gt; i < 65536; i += NGT) cvt8_store(p.in[12] + i * 8, p.WukN + i * 8);
    for (long i = gt; i < (long)MT * 32; i += NGT) { const long row = i >> 5, c = (i & 31) * 8;
        const float* src = row < MP ? p.in[5] + row * PLE + c : p.in[6] + (row - MP) * PLE + c; cvt8_store(src, p.Pb + row * PLE + c); }
    if (M0 & 8) for (long i0 = gt; i0 < (long)DECB * PAST * 72; i0 += 4 * NGT) {
        f32x4 a[4], b[4]; long rw[4]; int c[4];
#pragma unroll
        for (int q = 0; q < 4; ++q) { const long i = i0 + q * NGT; rw[q] = i / 72; c[q] = (int)(i % 72);
            const float* src = c[q] < 64 ? p.in[2] + rw[q] * KVL + c[q] * 8 : p.in[3] + rw[q] * ROPE + (c[q] - 64) * 8;
            if (i < (long)DECB * PAST * 72) { a[q] = *((const f32x4*)src); b[q] = *((const f32x4*)(src + 4)); } }
#pragma unroll
        for (int q = 0; q < 4; ++q) if (i0 + q * NGT < (long)DECB * PAST * 72)
            *(u32x4*)(p.CACHE + rw[q] * CROW + c[q] * 8) = (u32x4){pk2(a[q][0], a[q][1]), pk2(a[q][2], a[q][3]), pk2(b[q][0], b[q][1]), pk2(b[q][2], b[q][3])};
    }
    for (long i = gt; i < 192 * 256; i += NGT) { const int rr = (int)(i >> 8), c = (int)(i & 255) * 8; const int row = 5120 + (rr < 96 ? 32 + rr : 160 + (rr - 96));
        *(u32x4*)(p.WinT + (size_t)row * DM + c) = (u32x4){0u, 0u, 0u, 0u}; }
    if (M0 & 16) for (long i = gt; i < (long)SEQ * 160; i += NGT) {
        const int pos = (int)(i / 160), j = (int)(i % 160); const bool big = j < 128; const int ii = big ? j : j - 128;
        const double ex = -(double)(2 * ii) / (big ? 256.0 : 64.0) * 13.287712379549449;
        const double inv = exp2(ex); double rev = (double)pos * inv * 0.15915494309189535; rev -= floor(rev);
        const float fr = (float)rev; f32x2 cs; cs.x = __builtin_amdgcn_cosf(fr); cs.y = __builtin_amdgcn_sinf(fr);
        if (big) p.tabR[(size_t)pos * 128 + ii] = cs; else p.tab64[(size_t)pos * 32 + ii] = cs;
    }
    if (M0 & 32) for (int row = gw; row < MT; row += NGW) {
        const f32x4* xr = (const f32x4*)xrow(p, row) + lane; const f32x4* gr = (const f32x4*)p.in[7] + lane;
        f32x4 v[8]; float s = 0.f;
#pragma unroll
        for (int j = 0; j < 8; ++j) { v[j] = xr[64 * j]; s += (v[j].x * v[j].x + v[j].y * v[j].y) + (v[j].z * v[j].z + v[j].w * v[j].w); }
        const float r = rsqrtf(wave_sum(s) * (1.f / DM) + EPS);
        u32x2* o = (u32x2*)(p.XN + (size_t)row * DM) + lane;
#pragma unroll
        for (int j = 0; j < 8; ++j) { const f32x4 g = gr[64 * j]; u32x2 w; w.x = pk2(v[j].x * r * g.x, v[j].y * r * g.y); w.y = pk2(v[j].z * r * g.z, v[j].w * r * g.w); o[64 * j] = w; }
    }
}

struct EpiZ {
    static constexpr bool PERM = true, AFTER_DRAIN = false;
    Prm p;
    __device__ __forceinline__ void operator()(const f32x4 (&acc)[2][2][4][2], const pg8::Unit& u, int wr, int wc, int fr, int fq) const {
        const int pn = u.pn; const bool samp = u.pm >= 32; const int ci = 32 * wc + 8 * fq;
#pragma unroll
        for (int ai = 0; ai < 2; ++ai)
#pragma unroll
            for (int m = 0; m < 4; ++m) {
                const int row = u.pm * 256 + ai * 128 + wr * 64 + m * 16 + fr; const int pos = rowpos(row);
                if (pn < 8) {
                    const int head = pn & 3; const bool isk = pn >= 4;
                    const f32x4* tb = (const f32x4*)(p.tabR + (size_t)pos * 128 + ci);
                    float y1[8], y2[8];
#pragma unroll
                    for (int n = 0; n < 2; ++n) { const f32x4 t0 = tb[2 * n], t1 = tb[2 * n + 1]; const f32x4 x1 = acc[ai][0][m][n], x2 = acc[ai][1][m][n];
                        const float cs[4] = {t0.x, t0.z, t1.x, t1.z}, sn[4] = {t0.y, t0.w, t1.y, t1.w};
#pragma unroll
                        for (int e = 0; e < 4; ++e) { y1[4 * n + e] = x1[e] * cs[e] - x2[e] * sn[e]; y2[4 * n + e] = x2[e] * cs[e] + x1[e] * sn[e]; } }
                    if (isk) {
#pragma unroll
                        for (int e = 0; e < 8; ++e) { y1[e] *= 0.0625f; y2[e] *= 0.0625f; } }
                    bf16_t* dst = (isk ? p.RK : p.RQ) + (size_t)row * RW + head * 256 + ci;
                    *(u32x4*)dst = (u32x4){pk2(y1[0], y1[1]), pk2(y1[2], y1[3]), pk2(y1[4], y1[5]), pk2(y1[6], y1[7])};
                    *(u32x4*)(dst + 128) = (u32x4){pk2(y2[0], y2[1]), pk2(y2[2], y2[3]), pk2(y2[4], y2[5]), pk2(y2[6], y2[7])};
                    if (isk) {
                        const int l = samp ? ((row - MP) & 31) : (row & 63); const int L1 = samp ? 31 : 63;
                        const float kd = __builtin_amdgcn_exp2f((float)(L1 - l) * lg2gamma(head));
                        bf16_t* dt = p.RKt + (size_t)(head * 256 + ci) * MT + row;
#pragma unroll
                        for (int e = 0; e < 8; ++e) { dt[(size_t)e * MT] = f2bf(y1[e] * kd); dt[(size_t)(128 + e) * MT] = f2bf(y2[e] * kd); }
                    }
                } else if (pn < 12) {
                    const int head = pn - 8;
#pragma unroll
                    for (int bj = 0; bj < 2; ++bj)
#pragma unroll
                        for (int n = 0; n < 2; ++n)
#pragma unroll
                            for (int e = 0; e < 4; ++e) p.RVt[(size_t)(head * 256 + 128 * bj + ci + 4 * n + e) * MT + row] = f2bf(acc[ai][bj][m][n][e]);
                } else if (pn < 20) {
                    bf16_t* dst = pn < 16 ? p.RG + (size_t)row * RW + (pn - 12) * 256 : (pn < 18 ? p.ZCQ : p.ZCKV) + (size_t)row * 512 + ((pn - 16) & 1) * 256;
                    float s = 0.f;
#pragma unroll
                    for (int bj = 0; bj < 2; ++bj) { const f32x4 a = acc[ai][bj][m][0], b = acc[ai][bj][m][1];
                        *(u32x4*)(dst + 128 * bj + ci) = (u32x4){pk2(a[0], a[1]), pk2(a[2], a[3]), pk2(b[0], b[1]), pk2(b[2], b[3])};
                        s += (a[0] * a[0] + a[1] * a[1]) + (a[2] * a[2] + a[3] * a[3]) + (b[0] * b[0] + b[1] * b[1]) + (b[2] * b[2] + b[3] * b[3]); }
                    if (pn >= 16) { s += __shfl_xor(s, 16); s += __shfl_xor(s, 32); if (fq == 0) p.ssq1[(size_t)row * 16 + (pn - 16) * 4 + wc] = s; }
                } else if (wc == 0) {
                    const f32x4* tb = (const f32x4*)(p.tab64 + (size_t)pos * 32 + 8 * fq);
                    float y1[8], y2[8];
#pragma unroll
                    for (int n = 0; n < 2; ++n) { const f32x4 t0 = tb[2 * n], t1 = tb[2 * n + 1]; const f32x4 x1 = acc[ai][0][m][n], x2 = acc[ai][1][m][n];
                        const float cs[4] = {t0.x, t0.z, t1.x, t1.z}, sn[4] = {t0.y, t0.w, t1.y, t1.w};
#pragma unroll
                        for (int e = 0; e < 4; ++e) { y1[4 * n + e] = x1[e] * cs[e] - x2[e] * sn[e]; y2[4 * n + e] = x2[e] * cs[e] + x1[e] * sn[e]; } }
                    float* of = samp ? p.out + O_KRS + (size_t)(row - MP) * 64 + 8 * fq : p.out + O_KRP + (size_t)row * 64 + 8 * fq;
                    *(f32x4*)of = (f32x4){y1[0], y1[1], y1[2], y1[3]}; *(f32x4*)(of + 4) = (f32x4){y1[4], y1[5], y1[6], y1[7]};
                    *(f32x4*)(of + 32) = (f32x4){y2[0], y2[1], y2[2], y2[3]}; *(f32x4*)(of + 36) = (f32x4){y2[4], y2[5], y2[6], y2[7]};
                    bf16_t* ob = p.KRb + (size_t)row * 64 + 8 * fq;
                    *(u32x4*)ob = (u32x4){pk2(y1[0], y1[1]), pk2(y1[2], y1[3]), pk2(y1[4], y1[5]), pk2(y1[6], y1[7])};
                    *(u32x4*)(ob + 32) = (u32x4){pk2(y2[0], y2[1]), pk2(y2[2], y2[3]), pk2(y2[4], y2[5]), pk2(y2[6], y2[7])};
                }
            }
    }
};

__device__ __forceinline__ void ckv_pass(const Prm& p, int lane, int wave, int gw, int NGW) {
    for (int row = gw; row < MT; row += NGW) {
        const float* sq = p.ssq1 + (size_t)row * 16 + 8; float s = 0.f;
#pragma unroll
        for (int j = 0; j < 8; ++j) s += sq[j];
        const float r = rsqrtf(s * (1.f / KVL) + EPS);
        const u32x4 z = *(const u32x4*)(p.ZCKV + (size_t)row * KVL + 8 * lane);
        const f32x4 g0 = *(const f32x4*)(p.in[11] + 8 * lane), g1 = *(const f32x4*)(p.in[11] + 8 * lane + 4);
        f32x4 o0, o1;
        o0.x = bflo(z.x) * r * g0.x; o0.y = bfhi(z.x) * r * g0.y; o0.z = bflo(z.y) * r * g0.z; o0.w = bfhi(z.y) * r * g0.w;
        o1.x = bflo(z.z) * r * g1.x; o1.y = bfhi(z.z) * r * g1.y; o1.z = bflo(z.w) * r * g1.z; o1.w = bfhi(z.w) * r * g1.w;
        float* of = row < MP ? p.out + O_CKVP + (size_t)row * KVL + 8 * lane : p.out + O_CKVS + (size_t)(row - MP) * KVL + 8 * lane;
        *(f32x4*)of = o0; *(f32x4*)(of + 4) = o1;
        if (row >= MP) *(u32x4*)(p.CKVNs + (size_t)(row - MP) * KVL + 8 * lane) = (u32x4){pk2(o0.x, o0.y), pk2(o0.z, o0.w), pk2(o1.x, o1.y), pk2(o1.z, o1.w)};
    }
}


struct EpiQ {
    static constexpr bool PERM = true, AFTER_DRAIN = false;
    Prm p;
    __device__ __forceinline__ void operator()(const f32x4 (&acc)[2][2][4][2], const pg8::Unit& u, int wr, int wc, int fr, int fq) const {
        const int pn = u.pn; const int ci = 32 * wc + 8 * fq;
        float rqs[2][4];
#pragma unroll
        for (int ai = 0; ai < 2; ++ai)
#pragma unroll
            for (int m = 0; m < 4; ++m) { const int row = u.pm * 256 + ai * 128 + wr * 64 + m * 16 + fr;
                const f32x4 s0 = *(const f32x4*)(p.ssq1 + (size_t)row * 16), s1 = *(const f32x4*)(p.ssq1 + (size_t)row * 16 + 4);
                rqs[ai][m] = rsqrtf(((s0.x + s0.y) + (s0.z + s0.w) + (s1.x + s1.y) + (s1.z + s1.w)) * (1.f / QL) + EPS) * QSCALE; }
#pragma unroll
        for (int ai = 0; ai < 2; ++ai)
#pragma unroll
            for (int m = 0; m < 4; ++m) {
                const int row = u.pm * 256 + ai * 128 + wr * 64 + m * 16 + fr;
                const float rq = rqs[ai][m];
                if (pn < 4) {
#pragma unroll
                    for (int bj = 0; bj < 2; ++bj) { const f32x4 a = acc[ai][bj][m][0] * rq, b = acc[ai][bj][m][1] * rq;
                        *(u32x4*)(p.Q + (size_t)row * 1536 + (2 * pn + bj) * QKH + ci) = (u32x4){pk2(a[0], a[1]), pk2(a[2], a[3]), pk2(b[0], b[1]), pk2(b[2], b[3])}; }
                } else {
                    const int head = (pn - 4) * 4 + wc; const int pos = rowpos(row);
                    const f32x4* tb = (const f32x4*)(p.tab64 + (size_t)pos * 32 + 8 * fq);
                    float y1[8], y2[8];
#pragma unroll
                    for (int n = 0; n < 2; ++n) { const f32x4 t0 = tb[2 * n], t1 = tb[2 * n + 1]; const f32x4 x1 = acc[ai][0][m][n] * rq, x2 = acc[ai][1][m][n] * rq;
                        const float cs[4] = {t0.x, t0.z, t1.x, t1.z}, sn[4] = {t0.y, t0.w, t1.y, t1.w};
#pragma unroll
                        for (int e = 0; e < 4; ++e) { y1[4 * n + e] = x1[e] * cs[e] - x2[e] * sn[e]; y2[4 * n + e] = x2[e] * cs[e] + x1[e] * sn[e]; } }
                    bf16_t* dst = p.Q + (size_t)row * 1536 + head * QKH + NOPE + 8 * fq;
                    *(u32x4*)dst = (u32x4){pk2(y1[0], y1[1]), pk2(y1[2], y1[3]), pk2(y1[4], y1[5]), pk2(y1[6], y1[7])};
                    *(u32x4*)(dst + 32) = (u32x4){pk2(y2[0], y2[1]), pk2(y2[2], y2[3]), pk2(y2[4], y2[5]), pk2(y2[6], y2[7])};
                }
            }
    }
};
__device__ __forceinline__ float ckv_rscale(const float* ssq1, int row) {
    const f32x4 s0 = *(const f32x4*)(ssq1 + (size_t)row * 16 + 8), s1 = *(const f32x4*)(ssq1 + (size_t)row * 16 + 12);
    return rsqrtf(((s0.x + s0.y) + (s0.z + s0.w) + (s1.x + s1.y) + (s1.z + s1.w)) * (1.f / KVL) + EPS);
}
struct EpiKN {
    static constexpr bool PERM = true, AFTER_DRAIN = false;
    Prm p;
    __device__ __forceinline__ void operator()(const f32x4 (&acc)[2][2][4][2], const pg8::Unit& u, int wr, int wc, int fr, int fq) const {
        const int ci = u.pn * 256 + 32 * wc + 8 * fq;
        float rr[2][4];
#pragma unroll
        for (int ai = 0; ai < 2; ++ai)
#pragma unroll
            for (int m = 0; m < 4; ++m) rr[ai][m] = ckv_rscale(p.ssq1, u.pm * 256 + ai * 128 + wr * 64 + m * 16 + fr);
#pragma unroll
        for (int ai = 0; ai < 2; ++ai)
#pragma unroll
            for (int m = 0; m < 4; ++m) {
                const int row = u.pm * 256 + ai * 128 + wr * 64 + m * 16 + fr; const float r = rr[ai][m];
#pragma unroll
                for (int bj = 0; bj < 2; ++bj) { const f32x4 a = acc[ai][bj][m][0] * r, b = acc[ai][bj][m][1] * r;
                    *(u32x4*)(p.KN + (size_t)row * 1024 + 128 * bj + ci) = (u32x4){pk2(a[0], a[1]), pk2(a[2], a[3]), pk2(b[0], b[1]), pk2(b[2], b[3])}; }
            }
    }
};
struct EpiVT {
    static constexpr bool PERM = true, AFTER_DRAIN = false;
    Prm p;
    __device__ __forceinline__ void operator()(const f32x4 (&acc)[2][2][4][2], const pg8::Unit& u, int wr, int wc, int fr, int fq) const {
        const int ci = u.pn * 256 + 32 * wc + 8 * fq;
#pragma unroll
        for (int bj = 0; bj < 2; ++bj) {
            float r[8];
#pragma unroll
            for (int e = 0; e < 8; ++e) r[e] = ckv_rscale(p.ssq1, 128 * bj + ci + e);
#pragma unroll
            for (int ai = 0; ai < 2; ++ai)
#pragma unroll
                for (int m = 0; m < 4; ++m) {
                    const int row = u.pm * 256 + ai * 128 + wr * 64 + m * 16 + fr;
                    const f32x4 a = acc[ai][bj][m][0], b = acc[ai][bj][m][1];
                    *(u32x4*)(p.VTp + (size_t)row * MP + 128 * bj + ci) = (u32x4){pk2(a[0] * r[0], a[1] * r[1]), pk2(a[2] * r[2], a[3] * r[3]), pk2(b[0] * r[4], b[1] * r[5]), pk2(b[2] * r[6], b[3] * r[7])};
                }
        }
    }
};
struct EpiPP {
    static constexpr bool PERM = true, AFTER_DRAIN = false;
    bf16_t* O; int ldc;
    __device__ __forceinline__ void operator()(const f32x4 (&acc)[2][2][4][2], const pg8::Unit& u, int wr, int wc, int fr, int fq) const {
        const int ci = u.pn * 256 + 32 * wc + 8 * fq;
#pragma unroll
        for (int ai = 0; ai < 2; ++ai)
#pragma unroll
            for (int m = 0; m < 4; ++m) {
                const int row = u.pm * 256 + ai * 128 + wr * 64 + m * 16 + fr;
#pragma unroll
                for (int bj = 0; bj < 2; ++bj) { const f32x4 a = acc[ai][bj][m][0], b = acc[ai][bj][m][1];
                    *(u32x4*)(O + (size_t)row * ldc + 128 * bj + ci) = (u32x4){pk2(a[0], a[1]), pk2(a[2], a[3]), pk2(b[0], b[1]), pk2(b[2], b[3])}; }
            }
    }
};

__device__ __forceinline__ bf16x8 ld2x8(const bf16_t* p0) {
    const u32x2 a = *(const u32x2*)p0, b = *(const u32x2*)(p0 + 16);
    return __builtin_bit_cast(bf16x8, (u32x4){a.x, a.y, b.x, b.y});
}
template <int L> __device__ __forceinline__ void ret_stepA(const Prm& p, LAS unsigned char* lds, int cid, int h, int lane, int wave) {
    asm volatile("" : "+v"(lane));
    constexpr int NLB = L / 16, NPART = 8 / NLB, DVP = 256 / NPART, NDB = DVP / 16, NKS = L / 32;
    const int fr = lane & 15, fq = lane >> 4;
    const int row0 = (L == 64) ? cid * 64 : MP + (cid - 128) * 32;
    const int lb = wave % NLB, part = wave / NLB;
    const float lg = lg2gamma(h);
    bf16x8 qf[8];
    { const bf16_t* qp = p.RQ + (size_t)(row0 + 16 * lb + fr) * RW + h * 256 + 8 * fq;
#pragma unroll
      for (int ks = 0; ks < 8; ++ks) qf[ks] = *(const bf16x8*)(qp + 32 * ks); }
#define SB2() __builtin_amdgcn_sched_barrier(0)
    f32x4 sc[NLB];
#pragma unroll
    for (int mp = 0; mp < NLB; mp += 2) {
        bf16x8 kf[2][8];
#pragma unroll
        for (int d = 0; d < 2; ++d) { const int mb = mp + d; const int mbc = mb <= lb ? mb : lb;
            const bf16_t* kp = p.RK + (size_t)(row0 + 16 * mbc + fr) * RW + h * 256 + 8 * fq;
#pragma unroll
            for (int ks = 0; ks < 8; ++ks) kf[d][ks] = *(const bf16x8*)(kp + 32 * ks); }
        SB2();
#pragma unroll
        for (int d = 0; d < 2; ++d) { const int mb = mp + d; f32x4 a = {0.f, 0.f, 0.f, 0.f};
#pragma unroll
            for (int ks = 0; ks < 8; ++ks) a = mfma16(kf[d][ks], qf[ks], a);
            const int l = 16 * lb + fr;
#pragma unroll
            for (int rg = 0; rg < 4; ++rg) { const int mm = 16 * mb + 4 * fq + rg; sc[mb][rg] = (mb <= lb && l >= mm) ? a[rg] * __builtin_amdgcn_exp2f((float)(l - mm) * lg) : 0.f; } }
        SB2();
    }
    bf16x8 pf[NKS];
#pragma unroll
    for (int j = 0; j < NKS; ++j) pf[j] = pack8(sc[2 * j], sc[2 * j + 1]);
    { bf16x8 vf[NDB][NKS];
#pragma unroll
      for (int db = 0; db < NDB; ++db) { const bf16_t* vp = p.RVt + (size_t)(h * 256 + part * DVP + 16 * db + fr) * MT + row0 + 4 * fq;
#pragma unroll
          for (int j = 0; j < NKS; ++j) vf[db][j] = ld2x8(vp + 32 * j); }
      SB2();
#pragma unroll
      for (int db = 0; db < NDB; ++db) { f32x4 o = {0.f, 0.f, 0.f, 0.f};
#pragma unroll
          for (int j = 0; j < NKS; ++j) o = mfma16(vf[db][j], pf[j], o);
          *(f32x4*)(p.OINTRA + (size_t)(row0 + 16 * lb + fr) * RW + h * 256 + part * DVP + 16 * db + 4 * fq) = o; }
      SB2(); }
    { const bf16_t* xsrc = (L == 64) ? p.RVt : p.RKt; const bf16_t* ysrc = (L == 64) ? p.RKt : p.RVt;
      const float g32 = __builtin_amdgcn_exp2f(32.f * lg);
      LAS float* wt = (LAS float*)(lds + wave * 8704);
      bf16x8 xf[2][NKS];
#pragma unroll
      for (int a = 0; a < 2; ++a)
#pragma unroll
          for (int ks = 0; ks < NKS; ++ks) xf[a][ks] = *(const bf16x8*)(xsrc + (size_t)(h * 256 + 32 * wave + 16 * a + fr) * MT + row0 + 32 * ks + 8 * fq);
      float* dstbase = p.out + O_RETS + ((size_t)((L == 64 ? 0 : cid - 128) * 4 + h) * 256 + 32 * wave) * 256;
      bf16_t* kvbase = (bf16_t*)p.KVp + ((size_t)((L == 64 ? cid : 0) * 4 + h) * 256 + 32 * wave) * 256;
      const float* s0base = p.in[4] + ((size_t)((cid - 128) * 4 + h) * 256 + 32 * wave) * 256;
#pragma unroll
      for (int kg = 0; kg < 4; ++kg) {
          bf16x8 yf[4][NKS]; f32x4 s0v[8];
#pragma unroll
          for (int k4 = 0; k4 < 4; ++k4) { const bf16_t* kp = ysrc + (size_t)(h * 256 + 16 * (4 * kg + k4) + fr) * MT + row0 + 8 * fq;
#pragma unroll
              for (int ks = 0; ks < NKS; ++ks) yf[k4][ks] = *(const bf16x8*)(kp + 32 * ks); }
          if (L == 32) {
#pragma unroll
              for (int q = 0; q < 8; ++q) s0v[q] = *(const f32x4*)(s0base + (size_t)(4 * q + (lane >> 4)) * 256 + 64 * kg + 4 * (lane & 15));
          }
          SB2();
#pragma unroll
          for (int k4 = 0; k4 < 4; ++k4)
#pragma unroll
              for (int a = 0; a < 2; ++a) { f32x4 o = {0.f, 0.f, 0.f, 0.f};
#pragma unroll
                  for (int ks = 0; ks < NKS; ++ks) o = mfma16(xf[a][ks], yf[k4][ks], o);
#pragma unroll
                  for (int rg = 0; rg < 4; ++rg) wt[(16 * a + 4 * fq + rg) * 68 + 16 * k4 + fr] = o[rg]; }
          LDS_WAIT();
#pragma unroll
          for (int q = 0; q < 8; ++q) { const int r = 4 * q + (lane >> 4); f32x4 v = *(const LAS f32x4*)(wt + r * 68 + 4 * (lane & 15));
              if (L == 32) { v = s0v[q] * g32 + v; *(f32x4*)(dstbase + (size_t)r * 256 + 64 * kg + 4 * (lane & 15)) = v; }
              else *(u32x2*)(kvbase + (size_t)r * 256 + 64 * kg + 4 * (lane & 15)) = (u32x2){pk2(v[0], v[1]), pk2(v[2], v[3])}; }
          LDS_WAIT();
          SB2();
      } }
#undef SB2
}

template <int L> __device__ __forceinline__ void ret_stepA_lds(const Prm& p, LAS unsigned char* lds, int cid, int h, int lane, int wave) {
    asm volatile("" : "+v"(lane));
    constexpr int NLB = L / 16, NPART = 8 / NLB, DVP = 256 / NPART, NDB = DVP / 16, NKS = L / 32, TS = L + 8, NCH = L / 16, CPR = L / 8;
    const int fr = lane & 15, fq = lane >> 4, tid = wave * 64 + lane;
    const int row0 = (L == 64) ? cid * 64 : MP + (cid - 128) * 32;
    const int lb = wave % NLB, part = wave / NLB;
    const float lg = lg2gamma(h);
    LAS bf16_t* Ks = (LAS bf16_t*)lds; LAS bf16_t* Vts = (LAS bf16_t*)(lds + 34816); LAS bf16_t* Kts = (LAS bf16_t*)(lds + 71680);
    __syncthreads();
    { u32x4 tk[NCH], tv[NCH], tt[NCH];
#pragma unroll
      for (int i = 0; i < NCH; ++i) { const int id = tid + 512 * i;
          tk[i] = *(const u32x4*)(p.RK + (size_t)(row0 + (id >> 5)) * RW + h * 256 + (id & 31) * 8);
          tv[i] = *(const u32x4*)(p.RVt + (size_t)(h * 256 + id / CPR) * MT + row0 + (id % CPR) * 8);
          tt[i] = *(const u32x4*)(p.RKt + (size_t)(h * 256 + id / CPR) * MT + row0 + (id % CPR) * 8); }
#pragma unroll
      for (int i = 0; i < NCH; ++i) { const int id = tid + 512 * i;
          *(LAS u32x4*)(Ks + (id >> 5) * 264 + (id & 31) * 8) = tk[i];
          *(LAS u32x4*)(Vts + (id / CPR) * TS + (id % CPR) * 8) = tv[i];
          *(LAS u32x4*)(Kts + (id / CPR) * TS + (id % CPR) * 8) = tt[i]; } }
    bf16x8 qf[8];
    { const bf16_t* qp = p.RQ + (size_t)(row0 + 16 * lb + fr) * RW + h * 256 + 8 * fq;
#pragma unroll
      for (int ks = 0; ks < 8; ++ks) qf[ks] = *(const bf16x8*)(qp + 32 * ks); }
    LDS_WAIT();
    __syncthreads();
    f32x4 sc[NLB];
#pragma unroll
    for (int mb = 0; mb < NLB; ++mb) { f32x4 a = {0.f, 0.f, 0.f, 0.f};
        if (mb <= lb) {
#pragma unroll
            for (int ks = 0; ks < 8; ++ks) a = mfma16(*(const LAS bf16x8*)(Ks + (16 * mb + fr) * 264 + 8 * fq + 32 * ks), qf[ks], a); }
        const int l = 16 * lb + fr;
#pragma unroll
        for (int rg = 0; rg < 4; ++rg) { const int mm = 16 * mb + 4 * fq + rg; sc[mb][rg] = (mb <= lb && l >= mm) ? a[rg] * __builtin_amdgcn_exp2f((float)(l - mm) * lg) : 0.f; } }
    bf16x8 pf[NKS];
#pragma unroll
    for (int j = 0; j < NKS; ++j) pf[j] = pack8(sc[2 * j], sc[2 * j + 1]);
#pragma unroll
    for (int db = 0; db < NDB; ++db) { f32x4 o = {0.f, 0.f, 0.f, 0.f};
        const LAS bf16_t* vp = Vts + (part * DVP + 16 * db + fr) * TS + 4 * fq;
#pragma unroll
        for (int j = 0; j < NKS; ++j) { const u32x2 va = *(const LAS u32x2*)(vp + 32 * j), vb = *(const LAS u32x2*)(vp + 32 * j + 16);
            o = mfma16(__builtin_bit_cast(bf16x8, (u32x4){va.x, va.y, vb.x, vb.y}), pf[j], o); }
        *(f32x4*)(p.OINTRA + (size_t)(row0 + 16 * lb + fr) * RW + h * 256 + part * DVP + 16 * db + 4 * fq) = o; }
    __syncthreads();
    { LAS float* wt = (LAS float*)(lds + (wave < 4 ? wave * 8704 : 108544 + (wave - 4) * 8704));
      const LAS bf16_t* xs = (L == 64) ? Vts : Kts; const LAS bf16_t* ys = (L == 64) ? Kts : Vts;
      const float g32 = __builtin_amdgcn_exp2f(32.f * lg);
      bf16x8 xf[2][NKS];
#pragma unroll
      for (int a = 0; a < 2; ++a)
#pragma unroll
          for (int ks = 0; ks < NKS; ++ks) xf[a][ks] = *(const LAS bf16x8*)(xs + (32 * wave + 16 * a + fr) * TS + 32 * ks + 8 * fq);
      float* dstbase = p.out + O_RETS + ((size_t)((L == 64 ? 0 : cid - 128) * 4 + h) * 256 + 32 * wave) * 256;
      bf16_t* kvbase = (bf16_t*)p.KVp + ((size_t)((L == 64 ? cid : 0) * 4 + h) * 256 + 32 * wave) * 256;
      const float* s0base = p.in[4] + ((size_t)((cid - 128) * 4 + h) * 256 + 32 * wave) * 256;
#pragma unroll
      for (int kg = 0; kg < 4; ++kg) {
          f32x4 s0v[8];
          if (L == 32) {
#pragma unroll
              for (int q = 0; q < 8; ++q) s0v[q] = *(const f32x4*)(s0base + (size_t)(4 * q + (lane >> 4)) * 256 + 64 * kg + 4 * (lane & 15));
          }
#pragma unroll
          for (int k4 = 0; k4 < 4; ++k4)
#pragma unroll
              for (int a = 0; a < 2; ++a) { f32x4 o = {0.f, 0.f, 0.f, 0.f};
#pragma unroll
                  for (int ks = 0; ks < NKS; ++ks) o = mfma16(xf[a][ks], *(const LAS bf16x8*)(ys + (16 * (4 * kg + k4) + fr) * TS + 8 * fq + 32 * ks), o);
#pragma unroll
                  for (int rg = 0; rg < 4; ++rg) wt[(16 * a + 4 * fq + rg) * 68 + 16 * k4 + fr] = o[rg]; }
          LDS_WAIT();
#pragma unroll
          for (int q = 0; q < 8; ++q) { const int r = 4 * q + (lane >> 4); f32x4 v = *(const LAS f32x4*)(wt + r * 68 + 4 * (lane & 15));
              if (L == 32) { v = s0v[q] * g32 + v; *(f32x4*)(dstbase + (size_t)r * 256 + 64 * kg + 4 * (lane & 15)) = v; }
              else *(u32x2*)(kvbase + (size_t)r * 256 + 64 * kg + 4 * (lane & 15)) = (u32x2){pk2(v[0], v[1]), pk2(v[2], v[3])}; }
          LDS_WAIT();
      } }
    __syncthreads();
}

template <int M2 = 7> __device__ __forceinline__ void phase2(const Prm& p, LAS unsigned char* lds, int tid, int lane, int wave) {
    const int G = (int)gridDim.x, c = (int)blockIdx.x;
#ifndef SKIP_G1
    if (M2 & 1) { pg8::Gemm g{p.ZCQ, p.WuqT, MT, 1536, QL}; pg8::StaticOrder S; S.init(MT, 1536, G, c); S.wv = wave; EpiQ E{p}; pg8::gemm_phase<EpiQ, pg8::StaticOrder, true, true>(lds, g, S, E); }
#endif
#ifndef SKIP_G2
    if (M2 & 1) { pg8::Gemm g{p.ZCKV, p.WukT, MP, 1024, KVL}; pg8::StaticOrder S; S.init(MP, 1024, G, (c + 40) & 255); S.wv = wave; EpiKN E{p};        pg8::gemm_phase<EpiKN, pg8::StaticOrder, true, true>(lds, g, S, E); }
#endif
#ifndef SKIP_G3
    if (M2 & 1) { pg8::Gemm g{p.WuvTg, p.ZCKV, 1024, MP, KVL}; pg8::StaticOrder S; S.init(1024, MP, G, (c - 88) & 255); S.wv = wave; EpiVT E{p}; pg8::gemm_phase<EpiVT, pg8::StaticOrder, true, true>(lds, g, S, E); }
#endif
    { int t2 = lane_id(); asm volatile("" : "+v"(t2)); lane = t2; }
    const bool ckv_first = G != 256 || ((c >> 5) & 1) == 0;
    if (ckv_first) {
    if (M2 & 2) { if (G == 256) { if (c < 128) ckv_pass(p, lane, wave, c * NWAVES + wave, 512 * NWAVES); else { for (int k = 0; k < 3; ++k) ckv_pass(p, lane, wave, (128 + 128 * k + (c - 128)) * NWAVES + wave, 512 * NWAVES); } }
                  else ckv_pass(p, lane, wave, c * NWAVES + wave, G * NWAVES); }
    }
#ifndef SKIP_RA
    if (M2 & 28) for (int u = c; u < 640; u += G) {
        if ((M2 & 8) && !(M2 & 4) && u >= 512) continue;
        if ((M2 & 16) && !(M2 & 4) && u < 512) continue;
        const int cid = u >> 2, h = u & 3;
        if (cid < 128) ret_stepA_lds<64>(p, lds, cid, h, lane, wave); else ret_stepA_lds<32>(p, lds, cid, h, lane, wave);
    }
#endif
    if (!ckv_first) { int t4 = lane_id(); asm volatile("" : "+v"(t4)); lane = t4;
    if (M2 & 2) { if (G == 256) { if (c < 128) ckv_pass(p, lane, wave, c * NWAVES + wave, 512 * NWAVES); else { for (int k = 0; k < 3; ++k) ckv_pass(p, lane, wave, (128 + 128 * k + (c - 128)) * NWAVES + wave, 512 * NWAVES); } }
                  else ckv_pass(p, lane, wave, c * NWAVES + wave, G * NWAVES); }
    }

}
constexpr int P3_MAXU = 4;
__device__ const unsigned short p3_sched[256][P3_MAXU] = {
{1,624,368,65535},
{33,626,370,65535},
{65,628,372,65535},
{97,630,374,65535},
{129,632,376,65535},
{161,634,378,65535},
{193,636,380,65535},
{225,638,382,65535},
{3,625,369,65535},
{35,627,371,65535},
{67,629,373,65535},
{99,631,375,65535},
{131,633,377,65535},
{163,635,379,65535},
{195,637,381,65535},
{227,639,383,65535},
{5,608,400,65535},
{37,610,402,65535},
{69,612,404,65535},
{101,614,406,65535},
{133,616,408,65535},
{165,618,410,65535},
{197,620,412,65535},
{229,622,414,65535},
{7,609,401,65535},
{39,611,403,65535},
{71,613,405,65535},
{103,615,407,65535},
{135,617,409,65535},
{167,619,411,65535},
{199,621,413,65535},
{231,623,415,65535},
{9,592,416,65535},
{41,594,418,65535},
{73,596,420,65535},
{105,598,422,65535},
{137,600,424,65535},
{169,602,426,65535},
{201,604,428,65535},
{233,606,430,65535},
{11,593,417,65535},
{43,595,419,65535},
{75,597,421,65535},
{107,599,423,65535},
{139,601,425,65535},
{171,603,427,65535},
{203,605,429,65535},
{235,607,431,65535},
{13,576,432,65535},
{45,578,434,65535},
{77,580,436,65535},
{109,582,438,65535},
{141,584,440,65535},
{173,586,442,65535},
{205,588,444,65535},
{237,590,446,65535},
{15,577,433,65535},
{47,579,435,65535},
{79,581,437,65535},
{111,583,439,65535},
{143,585,441,65535},
{175,587,443,65535},
{207,589,445,65535},
{239,591,447,65535},
{17,560,448,65535},
{49,562,450,65535},
{81,564,452,65535},
{113,566,454,65535},
{145,568,456,65535},
{177,570,458,65535},
{209,572,460,65535},
{241,574,462,65535},
{19,561,449,65535},
{51,563,451,65535},
{83,565,453,65535},
{115,567,455,65535},
{147,569,457,65535},
{179,571,459,65535},
{211,573,461,65535},
{243,575,463,65535},
{21,544,464,65535},
{53,546,466,65535},
{85,548,468,65535},
{117,550,470,65535},
{149,552,472,65535},
{181,554,474,65535},
{213,556,476,65535},
{245,558,478,65535},
{23,545,465,65535},
{55,547,467,65535},
{87,549,469,65535},
{119,551,471,65535},
{151,553,473,65535},
{183,555,475,65535},
{215,557,477,65535},
{247,559,479,65535},
{25,528,480,65535},
{57,530,482,65535},
{89,532,484,65535},
{121,534,486,65535},
{153,536,488,65535},
{185,538,490,65535},
{217,540,492,65535},
{249,542,494,65535},
{27,529,481,65535},
{59,531,483,65535},
{91,533,485,65535},
{123,535,487,65535},
{155,537,489,65535},
{187,539,491,65535},
{219,541,493,65535},
{251,543,495,65535},
{29,512,496,65535},
{61,514,498,65535},
{93,516,500,65535},
{125,518,502,65535},
{157,520,504,65535},
{189,522,506,65535},
{221,524,508,65535},
{253,526,510,65535},
{31,513,497,65535},
{63,515,499,65535},
{95,517,501,65535},
{127,519,503,65535},
{159,521,505,65535},
{191,523,507,65535},
{223,525,509,65535},
{255,527,511,65535},
{0,752,256,65535},
{32,754,258,65535},
{64,756,260,65535},
{96,758,262,65535},
{128,760,264,65535},
{160,762,266,65535},
{192,764,268,65535},
{224,766,270,65535},
{2,753,257,65535},
{34,755,259,65535},
{66,757,261,65535},
{98,759,263,65535},
{130,761,265,65535},
{162,763,267,65535},
{194,765,269,65535},
{226,767,271,65535},
{4,736,272,65535},
{36,738,274,65535},
{68,740,276,65535},
{100,742,278,65535},
{132,744,280,65535},
{164,746,282,65535},
{196,748,284,65535},
{228,750,286,65535},
{6,737,273,65535},
{38,739,275,65535},
{70,741,277,65535},
{102,743,279,65535},
{134,745,281,65535},
{166,747,283,65535},
{198,749,285,65535},
{230,751,287,65535},
{8,720,288,65535},
{40,722,290,65535},
{72,724,292,65535},
{104,726,294,65535},
{136,728,296,65535},
{168,730,298,65535},
{200,732,300,65535},
{232,734,302,65535},
{10,721,289,65535},
{42,723,291,65535},
{74,725,293,65535},
{106,727,295,65535},
{138,729,297,65535},
{170,731,299,65535},
{202,733,301,65535},
{234,735,303,65535},
{12,704,304,65535},
{44,706,306,65535},
{76,708,308,65535},
{108,710,310,65535},
{140,712,312,65535},
{172,714,314,65535},
{204,716,316,65535},
{236,718,318,65535},
{14,705,305,65535},
{46,707,307,65535},
{78,709,309,65535},
{110,711,311,65535},
{142,713,313,65535},
{174,715,315,65535},
{206,717,317,65535},
{238,719,319,65535},
{16,688,320,65535},
{48,690,322,65535},
{80,692,324,65535},
{112,694,326,65535},
{144,696,328,65535},
{176,698,330,65535},
{208,700,332,65535},
{240,702,334,65535},
{18,689,321,65535},
{50,691,323,65535},
{82,693,325,65535},
{114,695,327,65535},
{146,697,329,65535},
{178,699,331,65535},
{210,701,333,65535},
{242,703,335,65535},
{20,672,336,65535},
{52,674,338,65535},
{84,676,340,65535},
{116,678,342,65535},
{148,680,344,65535},
{180,682,346,65535},
{212,684,348,65535},
{244,686,350,65535},
{22,673,337,65535},
{54,675,339,65535},
{86,677,341,65535},
{118,679,343,65535},
{150,681,345,65535},
{182,683,347,65535},
{214,685,349,65535},
{246,687,351,65535},
{24,656,352,65535},
{56,658,354,65535},
{88,660,356,65535},
{120,662,358,65535},
{152,664,360,65535},
{184,666,362,65535},
{216,668,364,65535},
{248,670,366,65535},
{26,657,353,65535},
{58,659,355,65535},
{90,661,357,65535},
{122,663,359,65535},
{154,665,361,65535},
{186,667,363,65535},
{218,669,365,65535},
{250,671,367,65535},
{28,640,384,65535},
{60,642,386,65535},
{92,644,388,65535},
{124,646,390,65535},
{156,648,392,65535},
{188,650,394,65535},
{220,652,396,65535},
{252,654,398,65535},
{30,641,385,65535},
{62,643,387,65535},
{94,645,389,65535},
{126,647,391,65535},
{158,649,393,65535},
{190,651,395,65535},
{222,653,397,65535},
{254,655,399,65535}
};

__device__ __forceinline__ void ret_scan(const Prm& p, int tid) {
    const long gt = (long)blockIdx.x * NTHR + tid, NGT = (long)gridDim.x * NTHR;
    for (long e = gt; e < 131072; e += NGT) {
        const int h = (int)(e >> 15), x = (int)(e & 32767) * 2;
        const float g64 = __builtin_amdgcn_exp2f(64.f * lg2gamma(h));
        float S0 = 0.f, S1 = 0.f;
        const unsigned* kv = (const unsigned*)((const bf16_t*)p.KVp + (size_t)h * 65536 + x); unsigned* sp = (unsigned*)(p.SPREV + (size_t)h * 65536 + x);
        for (int c0 = 0; c0 < 128; c0 += 32) {
            unsigned v[32];
#pragma unroll
            for (int j = 0; j < 32; ++j) v[j] = kv[(size_t)(c0 + j) * 131072];
#pragma unroll
            for (int j = 0; j < 32; ++j) { sp[(size_t)(c0 + j) * 131072] = pk2(S0, S1); S0 = g64 * S0 + bflo(v[j]); S1 = g64 * S1 + bfhi(v[j]); }
        }
        const int dv = x >> 8, dk = x & 255;
        p.out[O_RETP + (size_t)h * 65536 + dk * 256 + dv] = S0; p.out[O_RETP + (size_t)h * 65536 + (dk + 1) * 256 + dv] = S1;
    }
}

#define SB() __builtin_amdgcn_sched_barrier(0)
constexpr int AP_LDK = 208, AP_LDV = 80, AP_KBYTES = 64 * AP_LDK * 2, AP_VBYTES = 128 * AP_LDV * 2;
__device__ __forceinline__ void attn_prompt_unit(const Prm& p, LAS unsigned char* lds, int qb, int h, int tid, int lane, int wave) {
    asm volatile("" : "+v"(tid), "+v"(lane));
    const int fr = lane & 15, fq = lane >> 4;
    LAS bf16_t* Ks = (LAS bf16_t*)lds; LAS bf16_t* Vs = (LAS bf16_t*)(lds + AP_KBYTES);
    const int qrow = 128 * qb + 16 * wave + fr; const int qchunk = 2 * qb + (wave >> 2);
    bf16x8 qf[6];
#pragma unroll
    for (int ks = 0; ks < 6; ++ks) qf[ks] = *(const bf16x8*)(p.Q + (size_t)qrow * 1536 + h * QKH + 32 * ks + 8 * fq);
    float mrun = -1e30f, lrun = 0.f; f32x4 o[8];
#pragma unroll
    for (int db = 0; db < 8; ++db) o[db] = (f32x4){0.f, 0.f, 0.f, 0.f};
    const int ntile = 2 * qb + 2;
    u32x4 kreg[3], vreg[2];
    const int sr = tid >> 3, sc = tid & 7;
    const bf16_t* kn_src = p.KN + (size_t)sr * 1024 + h * 128 + sc * 8; const bf16_t* kr_src = p.KRb + (size_t)sr * 64 + sc * 8;
    const bf16_t* vt_src = p.VTp + (size_t)(h * 128 + sr) * MP + sc * 8;
    auto issue = [&](int kt) {
        const size_t key0 = (size_t)kt * 64;
        kreg[0] = *(const u32x4*)(kn_src + key0 * 1024); kreg[1] = *(const u32x4*)(kn_src + key0 * 1024 + 64); kreg[2] = *(const u32x4*)(kr_src + key0 * 64);
        vreg[0] = *(const u32x4*)(vt_src + key0); vreg[1] = *(const u32x4*)(vt_src + (size_t)64 * MP + key0);
    };
    constexpr int AP_STAGE = AP_KBYTES + AP_VBYTES;
#define AP_WRITE(buf) do { LAS bf16_t* kd = (LAS bf16_t*)(lds + (buf) * AP_STAGE) + sr * AP_LDK + sc * 8; *(LAS u32x4*)kd = kreg[0]; *(LAS u32x4*)(kd + 64) = kreg[1]; *(LAS u32x4*)(kd + 128) = kreg[2]; \
        LAS bf16_t* vd = (LAS bf16_t*)(lds + (buf) * AP_STAGE + AP_KBYTES) + sr * AP_LDV + 32 * (sc >> 2) + 16 * (sc & 1) + 4 * ((sc >> 1) & 1);        \
        *(LAS u32x2*)vd = (u32x2){vreg[0].x, vreg[0].y}; *(LAS u32x2*)(vd + 8) = (u32x2){vreg[0].z, vreg[0].w}; \
        *(LAS u32x2*)(vd + 64 * AP_LDV) = (u32x2){vreg[1].x, vreg[1].y}; *(LAS u32x2*)(vd + 64 * AP_LDV + 8) = (u32x2){vreg[1].z, vreg[1].w}; } while (0)
    issue(0);
    AP_WRITE(0);
    __syncthreads();
    for (int kt = 0; kt < ntile; ++kt) {
        Ks = (LAS bf16_t*)(lds + (kt & 1) * AP_STAGE); Vs = (LAS bf16_t*)(lds + (kt & 1) * AP_STAGE + AP_KBYTES);
        if (kt + 1 < ntile) issue(kt + 1);
        if (kt <= qchunk) {
            f32x4 s[4]; bf16x8 kf[2][6];
#define AP_LDK(buf, kb) do { _Pragma("unroll") for (int ks = 0; ks < 6; ++ks) kf[buf][ks] = *(const LAS bf16x8*)(Ks + (16 * (kb) + fr) * AP_LDK + 32 * ks + 8 * fq); } while (0)
            AP_LDK(0, 0);
            __builtin_amdgcn_s_setprio(1);
#pragma unroll
            for (int kb = 0; kb < 4; ++kb) { s[kb] = (f32x4){0.f, 0.f, 0.f, 0.f};
                if (kb < 3) AP_LDK((kb + 1) & 1, kb + 1);
                SB();
#pragma unroll
                for (int ks = 0; ks < 6; ++ks) s[kb] = mfma16(kf[kb & 1][ks], qf[ks], s[kb]);
                SB(); }
            bf16x8 vf[2][4];
#define AP_LDV(buf, g) do { _Pragma("unroll") for (int d2 = 0; d2 < 2; ++d2) { const LAS bf16_t* vp = Vs + (16 * (2 * (g) + d2) + fr) * AP_LDV + 8 * fq; \
                vf[buf][2 * d2] = *(const LAS bf16x8*)vp; vf[buf][2 * d2 + 1] = *(const LAS bf16x8*)(vp + 32); } } while (0)
            AP_LDV(0, 0);
            __builtin_amdgcn_s_setprio(0);
            SB();
            float mx = fmaxf(fmaxf(fmaxf(s[0][0], s[0][1]), fmaxf(s[0][2], s[0][3])), fmaxf(fmaxf(s[1][0], s[1][1]), fmaxf(s[1][2], s[1][3])));
            mx = fmaxf(mx, fmaxf(fmaxf(fmaxf(s[2][0], s[2][1]), fmaxf(s[2][2], s[2][3])), fmaxf(fmaxf(s[3][0], s[3][1]), fmaxf(s[3][2], s[3][3]))));
            mx = fmaxf(mx, __shfl_xor(mx, 16)); mx = fmaxf(mx, __shfl_xor(mx, 32));
            const float mnew = fmaxf(mrun, mx), alpha = __builtin_amdgcn_exp2f(mrun - mnew); mrun = mnew;
            float ps = 0.f;
#pragma unroll
            for (int kb = 0; kb < 4; ++kb)
#pragma unroll
                for (int rg = 0; rg < 4; ++rg) { s[kb][rg] = __builtin_amdgcn_exp2f(s[kb][rg] - mnew); ps += s[kb][rg]; }
            lrun = lrun * alpha + ps;
            const bf16x8 pf0 = pack8(s[0], s[1]), pf1 = pack8(s[2], s[3]);
            SB();
            __builtin_amdgcn_s_setprio(1);
#pragma unroll
            for (int g = 0; g < 4; ++g) {
                if (g < 3) AP_LDV((g + 1) & 1, g + 1);
                SB();
#pragma unroll
                for (int d2 = 0; d2 < 2; ++d2) { const int db = 2 * g + d2;
                    o[db] = o[db] * alpha;
                    o[db] = mfma16(vf[g & 1][2 * d2], pf0, o[db]);
                    o[db] = mfma16(vf[g & 1][2 * d2 + 1], pf1, o[db]); }
                SB(); }
            __builtin_amdgcn_s_setprio(0);
#undef AP_LDK
#undef AP_LDV
        }
        if (kt + 1 < ntile) AP_WRITE((kt + 1) & 1);
        __syncthreads();
    }
#undef AP_WRITE
    lrun += __shfl_xor(lrun, 16); lrun += __shfl_xor(lrun, 32);
    const float inv = 1.f / lrun;
#pragma unroll
    for (int db = 0; db < 8; ++db) { const f32x4 v = o[db] * inv;
        *(u32x2*)(p.ACat + (size_t)qrow * DM + MLAW + h * VH + 16 * db + 4 * fq) = (u32x2){pk2(v[0], v[1]), pk2(v[2], v[3])}; }
}

typedef float f32x16 __attribute__((ext_vector_type(16)));
__device__ __forceinline__ f32x16 mfma32(bf16x8 a, bf16x8 b, f32x16 c) { return __builtin_amdgcn_mfma_f32_32x32x16_bf16(a, b, c, 0, 0, 0); }
constexpr int A2_LDK = 200, A2_LDV = 72, A2_KB = 64 * A2_LDK * 2, A2_VB = 128 * A2_LDV * 2, A2_STAGE = A2_KB + A2_VB, A2_LDO = 136;
__device__ __forceinline__ void attn_prompt_unit2(const Prm& p, LAS unsigned char* lds, int qb, int h, int kh, int tid, int lane, int wave) {
    asm volatile("" : "+v"(tid), "+v"(lane));
    const int r = lane & 31, hh = lane >> 5;
    const int qrow = 256 * qb + 32 * wave + r; const int chunk = 4 * qb + (wave >> 1);
    bf16x8 qf[12];
#pragma unroll
    for (int ks = 0; ks < 12; ++ks) qf[ks] = *(const bf16x8*)(p.Q + (size_t)qrow * 1536 + h * QKH + 16 * ks + 8 * hh);
    float mrun = -1e30f, lrun = 0.f; f32x16 o[4];
#pragma unroll
    for (int db = 0; db < 4; ++db)
#pragma unroll
        for (int e = 0; e < 16; ++e) o[db][e] = 0.f;
    const int nsub = 2 * qb + 2;
    u32x4 kreg[3], vreg[2];
    const int sr = tid >> 3, sc = tid & 7;
    const bf16_t* kn_src = p.KN + (size_t)sr * 1024 + h * 128 + sc * 8; const bf16_t* kr_src = p.KRb + (size_t)sr * 64 + sc * 8;
    const bf16_t* vt_src = p.VTp + (size_t)(h * 128 + sr) * MP + sc * 8;
    auto issue = [&](int i) {
        const size_t key0 = (size_t)(2 * i + kh) * 64;
        kreg[0] = *(const u32x4*)(kn_src + key0 * 1024); kreg[1] = *(const u32x4*)(kn_src + key0 * 1024 + 64); kreg[2] = *(const u32x4*)(kr_src + key0 * 64);
        vreg[0] = *(const u32x4*)(vt_src + key0); vreg[1] = *(const u32x4*)(vt_src + (size_t)64 * MP + key0);
    };
#define A2_WRITE(buf) do { LAS bf16_t* kd = (LAS bf16_t*)(lds + (buf) * A2_STAGE) + sr * A2_LDK + sc * 8; *(LAS u32x4*)kd = kreg[0]; *(LAS u32x4*)(kd + 64) = kreg[1]; *(LAS u32x4*)(kd + 128) = kreg[2]; \
        LAS bf16_t* vd = (LAS bf16_t*)(lds + (buf) * A2_STAGE + A2_KB) + sr * A2_LDV + 16 * (sc >> 1) + 4 * (sc & 1); \
        *(LAS u32x2*)vd = (u32x2){vreg[0].x, vreg[0].y}; *(LAS u32x2*)(vd + 8) = (u32x2){vreg[0].z, vreg[0].w}; \
        *(LAS u32x2*)(vd + 64 * A2_LDV) = (u32x2){vreg[1].x, vreg[1].y}; *(LAS u32x2*)(vd + 64 * A2_LDV + 8) = (u32x2){vreg[1].z, vreg[1].w}; } while (0)
    issue(0);
    A2_WRITE(0);
    __syncthreads();
    for (int i = 0; i < nsub; ++i) {
        const LAS bf16_t* Ks = (const LAS bf16_t*)(lds + (i & 1) * A2_STAGE); const LAS bf16_t* Vs = (const LAS bf16_t*)(lds + (i & 1) * A2_STAGE + A2_KB);
        if (i + 1 < nsub) issue(i + 1);
        if (2 * i + kh <= chunk) {
            const LAS bf16_t* vp = Vs + r * A2_LDV + 8 * hh;
#pragma unroll
            for (int blk = 0; blk < 2; ++blk) {
                f32x16 s;
                { const LAS bf16_t* kp = Ks + (32 * blk + r) * A2_LDK + 8 * hh; bf16x8 kf[2];
#define A2_LDK1(ks) do { if ((ks) < 12) kf[(ks) & 1] = *(const LAS bf16x8*)(kp + 16 * (ks)); } while (0)
                  A2_LDK1(0); A2_LDK1(1);
#pragma unroll
                  for (int e = 0; e < 16; ++e) s[e] = 0.f;
                  __builtin_amdgcn_s_setprio(1);
#pragma unroll
                  for (int ks = 0; ks < 12; ++ks) { SB(); s = mfma32(kf[ks & 1], qf[ks], s); A2_LDK1(ks + 2); SB(); }
                  __builtin_amdgcn_s_setprio(0);
#undef A2_LDK1
                }
                bf16x8 vf[4];
#define A2_LDV1(n) do { if ((n) < 8) vf[(n) & 3] = *(const LAS bf16x8*)(vp + 32 * ((n) >> 1) * A2_LDV + 32 * blk + 16 * ((n) & 1)); } while (0)
                A2_LDV1(0); A2_LDV1(1); A2_LDV1(2); A2_LDV1(3);
                float mx = s[0];
#pragma unroll
                for (int e = 1; e < 16; ++e) mx = fmaxf(mx, s[e]);
                mx = fmaxf(mx, __shfl_xor(mx, 32));
                if (__builtin_amdgcn_ballot_w64(mx > mrun + 8.f) != 0ull) {
                    const float mnew = fmaxf(mrun, mx), alpha = __builtin_amdgcn_exp2f(mrun - mnew); mrun = mnew; lrun *= alpha;
#pragma unroll
                    for (int db = 0; db < 4; ++db) o[db] = o[db] * alpha;
                }
                float ps = 0.f;
#pragma unroll
                for (int e = 0; e < 16; ++e) { s[e] = __builtin_amdgcn_exp2f(s[e] - mrun); ps += s[e]; }
                lrun += ps;
                const bf16x8 pf0 = pack8((f32x4){s[0], s[1], s[2], s[3]}, (f32x4){s[4], s[5], s[6], s[7]}), pf1 = pack8((f32x4){s[8], s[9], s[10], s[11]}, (f32x4){s[12], s[13], s[14], s[15]});
                __builtin_amdgcn_s_setprio(1);
#pragma unroll
                for (int n = 0; n < 8; ++n) { SB(); o[n >> 1] = mfma32(vf[n & 3], (n & 1) ? pf1 : pf0, o[n >> 1]); A2_LDV1(n + 4); SB(); }
                __builtin_amdgcn_s_setprio(0);
#undef A2_LDV1
            }
        }
        if (i + 1 < nsub) A2_WRITE((i + 1) & 1);
        __syncthreads();
    }
#undef A2_WRITE
    lrun += __shfl_xor(lrun, 32);
    const float inv = lrun > 0.f ? 1.f / lrun : 0.f;
    LAS bf16_t* ot = (LAS bf16_t*)(lds + wave * (32 * A2_LDO * 2));
#pragma unroll
    for (int db = 0; db < 4; ++db)
#pragma unroll
        for (int g4 = 0; g4 < 4; ++g4) *(LAS u32x2*)(ot + r * A2_LDO + 32 * db + 8 * g4 + 4 * hh) = (u32x2){pk2(o[db][4 * g4] * inv, o[db][4 * g4 + 1] * inv), pk2(o[db][4 * g4 + 2] * inv, o[db][4 * g4 + 3] * inv)};
    LDS_WAIT();
    bf16_t* po = p.PARTO + ((size_t)kh * MP + 256 * qb + 32 * wave) * MLAW + h * VH;
#pragma unroll
    for (int it = 0; it < 8; ++it) { const int rr = 4 * it + (lane >> 4), cc = lane & 15;
        *(u32x4*)(po + (size_t)rr * MLAW + 8 * cc) = *(const LAS u32x4*)(ot + rr * A2_LDO + 8 * cc); }
    if (hh == 0) p.PARTML[((size_t)kh * MP + qrow) * MH + h] = (f32x2){mrun, lrun};
    LDS_WAIT();
    __syncthreads();
}

constexpr int AS_LD = 592;
__device__ __forceinline__ s16x4 tr16(const LAS bf16_t* a) { return __builtin_bit_cast(s16x4, __builtin_amdgcn_ds_read_tr16_b64_v4i16((LAS s16x4*)a)); }
__device__ __forceinline__ void attn_sample_unit(const Prm& p, LAS unsigned char* lds, int b, int qq, int kh, int tid, int lane, int wave) {
    asm volatile("" : "+v"(tid), "+v"(lane));
    const int fr = lane & 15, fq = lane >> 4;
    LAS bf16_t* Ts = (LAS bf16_t*)lds;
    const int rgp = wave & 3, dh = wave >> 2; const int head = 2 * qq + (rgp >> 1), t0 = 16 * (rgp & 1);
    const int row = MP + b * 32 + t0 + fr;
    LAS bf16x8* QLs = (LAS bf16x8*)(lds + 64 * AS_LD * 2) + rgp * 16 * 64;
    LAS f32x4* XS = (LAS f32x4*)(lds + 64 * AS_LD * 2 + 65536);
    bf16x8 qrf[2];
    { bf16x8 qn[4];
#pragma unroll
      for (int ks = 0; ks < 4; ++ks) qn[ks] = *(const bf16x8*)(p.Q + (size_t)row * 1536 + head * QKH + 32 * ks + 8 * fq);
#pragma unroll
      for (int jb = 0; jb < 8; jb += 4) {
          bf16x8 wf[4][2][4];
#pragma unroll
          for (int jj = 0; jj < 4; ++jj) { const int j = 8 * dh + jb + jj; const bf16_t* w0 = p.WukN + (size_t)(32 * j + fr) * 1024 + head * 128 + 8 * fq; const bf16_t* w1 = w0 + (size_t)16 * 1024;
#pragma unroll
              for (int ks = 0; ks < 4; ++ks) { wf[jj][0][ks] = *(const bf16x8*)(w0 + 32 * ks); wf[jj][1][ks] = *(const bf16x8*)(w1 + 32 * ks); } }
          __builtin_amdgcn_sched_barrier(0);
#pragma unroll
          for (int jj = 0; jj < 4; ++jj) { const int j = 8 * dh + jb + jj; f32x4 a0 = {0.f, 0.f, 0.f, 0.f}, a1 = {0.f, 0.f, 0.f, 0.f};
#pragma unroll
              for (int ks = 0; ks < 4; ++ks) { a0 = mfma16(wf[jj][0][ks], qn[ks], a0); a1 = mfma16(wf[jj][1][ks], qn[ks], a1); }
              QLs[j * 64 + lane] = pack8(a0, a1); }
          __builtin_amdgcn_sched_barrier(0); }
#pragma unroll
      for (int ks = 0; ks < 2; ++ks) qrf[ks] = *(const bf16x8*)(p.Q + (size_t)row * 1536 + head * QKH + NOPE + 32 * ks + 8 * fq); }
    float mrun = -1e30f, lrun = 0.f; f32x4 o[16];
#pragma unroll
    for (int db = 0; db < 16; ++db) o[db] = (f32x4){0.f, 0.f, 0.f, 0.f};
    f32x4 tra[9], trb[9];
    const int sr = tid >> 3, sc = tid & 7;
    const float* cl_src = p.in[2] + ((size_t)b * PAST + sr) * KVL + sc * 8; const float* cr_src = p.in[3] + ((size_t)b * PAST + sr) * ROPE + sc * 8;
    auto issue_part = [&](int kt, int part) {
#pragma unroll
        for (int i = 0; i < 9; ++i) if (i / 3 == part) { const float* s_ = i < 8 ? cl_src + (size_t)kt * 64 * KVL + i * 64 : cr_src + (size_t)kt * 64 * ROPE; tra[i] = *(const f32x4*)s_; trb[i] = *(const f32x4*)(s_ + 4); }
    };
    auto issue = [&](int kt) {
        if (kt < 64) { issue_part(kt, 0); issue_part(kt, 1); issue_part(kt, 2);
        } else if (sr < 32) {
#pragma unroll
            for (int i = 0; i < 9; ++i) { const u32x4 w = i < 8 ? *(const u32x4*)(p.CKVNs + (size_t)(b * 32 + sr) * KVL + sc * 8 + i * 64) : *(const u32x4*)(p.KRb + (size_t)(MP + b * 32 + sr) * 64 + sc * 8);
                tra[i] = (f32x4){bflo(w.x), bfhi(w.x), bflo(w.y), bfhi(w.y)}; trb[i] = (f32x4){bflo(w.z), bfhi(w.z), bflo(w.w), bfhi(w.w)}; }
        } else {
#pragma unroll
            for (int i = 0; i < 9; ++i) { tra[i] = (f32x4){0.f, 0.f, 0.f, 0.f}; trb[i] = tra[i]; }
        }
    };
    const int kt0 = kh ? 32 : 0, kt1 = kh ? 65 : 32;
    issue(kt0);
    for (int kt = kt0; kt < kt1; ++kt) {
        { LAS bf16_t* td = Ts + sr * AS_LD + 32 * (sc >> 2) + 16 * (sc & 1) + 4 * ((sc >> 1) & 1);
#pragma unroll
          for (int i = 0; i < 8; ++i) { *(LAS u32x2*)(td + i * 64) = (u32x2){pk2(tra[i].x, tra[i].y), pk2(tra[i].z, tra[i].w)}; *(LAS u32x2*)(td + i * 64 + 8) = (u32x2){pk2(trb[i].x, trb[i].y), pk2(trb[i].z, trb[i].w)}; }
          *(LAS u32x4*)(Ts + sr * AS_LD + 512 + sc * 8) = (u32x4){pk2(tra[8].x, tra[8].y), pk2(tra[8].z, tra[8].w), pk2(trb[8].x, trb[8].y), pk2(trb[8].z, trb[8].w)}; }
        __syncthreads();
        if (kt + 1 < kt1) { if (kt + 1 < 64) issue_part(kt + 1, 0); else issue(kt + 1); }
        f32x4 s[4];
        { f32x4 so[2] = {(f32x4){0.f, 0.f, 0.f, 0.f}, (f32x4){0.f, 0.f, 0.f, 0.f}};
          const LAS bf16_t* tp = Ts + (32 * dh + fr) * AS_LD + 8 * fq;
          bf16x8 yv[2], xv[2];
#define AS_LDX(d, j) do { if ((j) < 18) xv[d] = *(const LAS bf16x8*)(tp + 16 * (d) * AS_LD + 32 * (j)); } while (0)
          yv[0] = QLs[lane];
          AS_LDX(0, 0); AS_LDX(1, 0);
          __builtin_amdgcn_s_setprio(1);
#pragma unroll
          for (int j = 0; j < 18; ++j) {
              if (j < 15) yv[(j + 1) & 1] = QLs[(j + 1) * 64 + lane];
#pragma unroll
              for (int d = 0; d < 2; ++d) { SB(); so[d] = mfma16(xv[d], j < 16 ? yv[j & 1] : qrf[j - 16], so[d]); AS_LDX(d, j + 1); SB(); } }
#undef AS_LDX
          __builtin_amdgcn_s_setprio(0);
          if (kt + 1 < kt1 && kt + 1 < 64) issue_part(kt + 1, 1);
          XS[((rgp * 2 + dh) * 2 + 0) * 64 + lane] = so[0]; XS[((rgp * 2 + dh) * 2 + 1) * 64 + lane] = so[1];
          __syncthreads();
          const f32x4 t0 = XS[((rgp * 2 + (dh ^ 1)) * 2 + 0) * 64 + lane], t1 = XS[((rgp * 2 + (dh ^ 1)) * 2 + 1) * 64 + lane];
#pragma unroll
          for (int e = 0; e < 4; ++e) { s[0][e] = dh ? t0[e] : so[0][e]; s[1][e] = dh ? t1[e] : so[1][e]; s[2][e] = dh ? so[0][e] : t0[e]; s[3][e] = dh ? so[1][e] : t1[e]; }
        }
        if (kt == 64) { s[2] = (f32x4){-1e30f, -1e30f, -1e30f, -1e30f}; s[3] = s[2]; }
        float mx = fmaxf(fmaxf(fmaxf(s[0][0], s[0][1]), fmaxf(s[0][2], s[0][3])), fmaxf(fmaxf(s[1][0], s[1][1]), fmaxf(s[1][2], s[1][3])));
        mx = fmaxf(mx, fmaxf(fmaxf(fmaxf(s[2][0], s[2][1]), fmaxf(s[2][2], s[2][3])), fmaxf(fmaxf(s[3][0], s[3][1]), fmaxf(s[3][2], s[3][3]))));
        mx = fmaxf(mx, __shfl_xor(mx, 16)); mx = fmaxf(mx, __shfl_xor(mx, 32));
        const float mnew = fmaxf(mrun, mx), alpha = __builtin_amdgcn_exp2f(mrun - mnew); mrun = mnew;
        float ps = 0.f;
#pragma unroll
        for (int kb = 0; kb < 4; ++kb)
#pragma unroll
            for (int rg = 0; rg < 4; ++rg) { s[kb][rg] = __builtin_amdgcn_exp2f(s[kb][rg] - mnew); ps += s[kb][rg]; }
        lrun = lrun * alpha + ps;
        if (kt + 1 < kt1 && kt + 1 < 64) issue_part(kt + 1, 2);
        const bf16x8 pf0 = pack8(s[0], s[1]), pf1 = pack8(s[2], s[3]);
        const LAS bf16_t* tb = Ts + (4 * fq + (fr >> 2)) * AS_LD + 256 * dh + 4 * (fr & 3);
        { s16x4 tv[2][4];
#define AS_LDT(buf, db) do { _Pragma("unroll") for (int i = 0; i < 4; ++i) tv[buf][i] = tr16(tb + 16 * i * AS_LD + 16 * (db)); } while (0)
          AS_LDT(0, 0); AS_LDT(1, 1);
          __builtin_amdgcn_s_setprio(1);
#pragma unroll
          for (int db = 0; db < 16; ++db) {
              SB();
              const s16x4 x0 = tv[db & 1][0], x1 = tv[db & 1][1], x2 = tv[db & 1][2], x3 = tv[db & 1][3];
              o[db] = o[db] * alpha;
              o[db] = mfma16((bf16x8){x0[0], x0[1], x0[2], x0[3], x1[0], x1[1], x1[2], x1[3]}, pf0, o[db]);
              o[db] = mfma16((bf16x8){x2[0], x2[1], x2[2], x2[3], x3[0], x3[1], x3[2], x3[3]}, pf1, o[db]);
              if (db < 14) AS_LDT(db & 1, db + 2);
              SB(); }
          __builtin_amdgcn_s_setprio(0);
#undef AS_LDT
        }
        __syncthreads();
    }
    lrun += __shfl_xor(lrun, 16); lrun += __shfl_xor(lrun, 32);
    const float inv = 1.f / lrun;
    bf16x8 cf[8];
#pragma unroll
    for (int j = 0; j < 8; ++j) cf[j] = pack8(o[2 * j] * inv, o[2 * j + 1] * inv);
    f32x4 r8[8];
#pragma unroll
    for (int db0 = 0; db0 < 8; db0 += 4) {
        u32x2 wa[4][8], wb[4][8];
#pragma unroll
        for (int d = 0; d < 4; ++d) { const bf16_t* wp = p.WuvT + (size_t)(head * 128 + 16 * (db0 + d) + fr) * KVL + 256 * dh + 16 * (fq & 1) + 4 * (fq >> 1);
#pragma unroll
            for (int j = 0; j < 8; ++j) { wa[d][j] = *(const u32x2*)(wp + 32 * j); wb[d][j] = *(const u32x2*)(wp + 32 * j + 8); } }
        __builtin_amdgcn_sched_barrier(0);
#pragma unroll
        for (int d = 0; d < 4; ++d) { const int ddb = db0 + d; r8[ddb] = (f32x4){0.f, 0.f, 0.f, 0.f};
#pragma unroll
            for (int j = 0; j < 8; ++j) r8[ddb] = mfma16(__builtin_bit_cast(bf16x8, (u32x4){wa[d][j].x, wa[d][j].y, wb[d][j].x, wb[d][j].y}), cf[j], r8[ddb]); }
        __builtin_amdgcn_sched_barrier(0); }
    LAS f32x4* xch = (LAS f32x4*)lds + (rgp * 8) * 64 + lane;
    if (dh == 1) {
#pragma unroll
        for (int ddb = 0; ddb < 8; ++ddb) xch[ddb * 64] = r8[ddb];
    }
    __syncthreads();
    if (dh == 0) {
#pragma unroll
        for (int ddb = 0; ddb < 8; ++ddb) { const f32x4 v = r8[ddb] + xch[ddb * 64];
            *(u32x2*)((bf16_t*)p.CACHE + ((size_t)kh * MS + (row - MP)) * MLAW + head * VH + 16 * ddb + 4 * fq) = (u32x2){pk2(v[0], v[1]), pk2(v[2], v[3])}; }
        if (fq == 0) ((f32x2*)((bf16_t*)p.CACHE + (size_t)2 * MS * MLAW))[((size_t)kh * MS + (row - MP)) * MH + head] = (f32x2){mrun, lrun};
    }
    __syncthreads();
}

template <int MODE = 7> __device__ __forceinline__ void phase3(const Prm& p, LAS unsigned char* lds, int tid, int lane, int wave) {
    const int scan_pos = gridDim.x != 256 ? 0 : (int)((blockIdx.x >> 5) & 3);
    if ((MODE & 4) && scan_pos == 0) ret_scan(p, tid);
    if (gridDim.x == 256) {
        bool scanned = scan_pos == 0;
        int nu = 0;
#pragma unroll
        for (int i = 0; i < P3_MAXU; ++i) nu += (p3_sched[blockIdx.x][i] != 0xFFFF) ? 1 : 0;
        const bool rev = ((blockIdx.x >> 5) & 1) != 0;
        for (int ii = 0; ii < nu; ++ii) { const int i = rev ? nu - 1 - ii : ii;
            const int u = p3_sched[blockIdx.x][i];
            if ((MODE & 4) && !scanned && ii == scan_pos) { ret_scan(p, tid); scanned = true; }
            if (u < 256) { if (MODE & 1) attn_sample_unit(p, lds, u >> 3, (u >> 1) & 3, u & 1, tid, lane, wave); }
            else if (MODE & 2) { const int v = u - 256; attn_prompt_unit2(p, lds, v >> 4, (v >> 1) & 7, v & 1, tid, lane, wave); }
        }
        if ((MODE & 4) && !scanned) ret_scan(p, tid);
        return;
    }
    const int G = (int)gridDim.x, c = (int)blockIdx.x;
    for (int u = c; u < 256 + 512; u += G) {
        if ((MODE & 1) && u < 256) attn_sample_unit(p, lds, u >> 3, (u >> 1) & 3, u & 1, tid, lane, wave);
        if ((MODE & 2) && u >= 256) { const int v = u - 256; attn_prompt_unit2(p, lds, v >> 4, (v >> 1) & 7, v & 1, tid, lane, wave); }
    }
}

__device__ __forceinline__ float silu_f(float x) { return x / (1.f + __expf(-x)); }
template <int L> __device__ __forceinline__ void ret_stepC(const Prm& p, int cid, int hp, int lane, int wave) {
    asm volatile("" : "+v"(lane));
    constexpr int NLB = L / 16;
    const int fr = lane & 15, fq = lane >> 4;
    const int lb = wave % NLB, h = (L == 64 ? 2 * hp : 0) + wave / NLB;
    const int row0 = (L == 64) ? cid * 64 : MP + (cid - 128) * 32;
    const int row = row0 + 16 * lb + fr;
    const bf16_t* Sp = (L == 64) ? p.SPREV + (size_t)(cid * 4 + h) * 65536 : p.S0T + (size_t)((cid - 128) * 4 + h) * 65536;
    bf16x8 qf[8];
    { const bf16_t* qp = p.RQ + (size_t)row * RW + h * 256 + 8 * fq;
#pragma unroll
      for (int ks = 0; ks < 8; ++ks) qf[ks] = *(const bf16x8*)(qp + 32 * ks); }
    const float inner = __builtin_amdgcn_exp2f((float)(16 * lb + fr + 1) * lg2gamma(h));
    f32x4 o[16]; float sum = 0.f;
#pragma unroll
    for (int vg = 0; vg < 8; ++vg) {
        bf16x8 sf[2][8]; f32x4 it[2];
#pragma unroll
        for (int d = 0; d < 2; ++d) { const bf16_t* sp = Sp + (size_t)(16 * (2 * vg + d) + fr) * 256 + 8 * fq;
#pragma unroll
            for (int ks = 0; ks < 8; ++ks) sf[d][ks] = *(const bf16x8*)(sp + 32 * ks);
            it[d] = *(const f32x4*)(p.OINTRA + (size_t)row * RW + h * 256 + 16 * (2 * vg + d) + 4 * fq); }
        __builtin_amdgcn_sched_barrier(0);
#pragma unroll
        for (int d = 0; d < 2; ++d) { const int vb = 2 * vg + d; f32x4 a = {0.f, 0.f, 0.f, 0.f};
#pragma unroll
            for (int ks = 0; ks < 8; ++ks) a = mfma16(sf[d][ks], qf[ks], a);
            o[vb] = a * inner + it[d]; sum += (o[vb][0] + o[vb][1]) + (o[vb][2] + o[vb][3]); }
        __builtin_amdgcn_sched_barrier(0);
    }
    sum += __shfl_xor(sum, 16); sum += __shfl_xor(sum, 32);
    const float mu = sum * (1.f / 256.f); float vs = 0.f;
#pragma unroll
    for (int vb = 0; vb < 16; ++vb) { o[vb] = o[vb] - mu; vs += (o[vb][0] * o[vb][0] + o[vb][1] * o[vb][1]) + (o[vb][2] * o[vb][2] + o[vb][3] * o[vb][3]); }
    vs += __shfl_xor(vs, 16); vs += __shfl_xor(vs, 32);
    const float rstd = rsqrtf(vs * (1.f / 256.f) + EPS);
#pragma unroll
    for (int vb = 0; vb < 16; ++vb) {
        const int col = h * 256 + 16 * vb + 4 * fq;
        const f32x4 g = *(const f32x4*)(p.in[14] + col); const u32x2 rgw = *(const u32x2*)(p.RG + (size_t)row * RW + col);
        const float y0 = o[vb][0] * rstd * g[0] * silu_f(bflo(rgw.x)), y1 = o[vb][1] * rstd * g[1] * silu_f(bfhi(rgw.x));
        const float y2 = o[vb][2] * rstd * g[2] * silu_f(bflo(rgw.y)), y3 = o[vb][3] * rstd * g[3] * silu_f(bfhi(rgw.y));
        *(u32x2*)(p.ACat + (size_t)row * DM + col) = (u32x2){pk2(y0, y1), pk2(y2, y3)};
    }
}
__device__ __forceinline__ void mla_norm_pass(const Prm& p, int lane, int wave, int gw, int NGW) {
    for (int row = gw; row < MT; row += NGW) {
        bf16_t* base = p.ACat + (size_t)row * DM + MLAW + 8 * lane;
        float v[16];
        if (row < MP) {
#pragma unroll
            for (int k = 0; k < 2; ++k) { const int c0 = 8 * lane + 512 * k, head = c0 >> 7;
                const u32x4 a = *(const u32x4*)(p.PARTO + (size_t)row * MLAW + c0), b = *(const u32x4*)(p.PARTO + ((size_t)MP + row) * MLAW + c0);
                const f32x2 ml1 = p.PARTML[(size_t)row * MH + head], ml2 = p.PARTML[((size_t)MP + row) * MH + head];
                const float m = fmaxf(ml1.x, ml2.x); const float w1 = ml1.y * __builtin_amdgcn_exp2f(ml1.x - m), w2 = ml2.y * __builtin_amdgcn_exp2f(ml2.x - m);
                const float iw = 1.f / (w1 + w2), f1 = w1 * iw, f2 = w2 * iw;
                v[8 * k + 0] = bflo(a.x) * f1 + bflo(b.x) * f2; v[8 * k + 1] = bfhi(a.x) * f1 + bfhi(b.x) * f2; v[8 * k + 2] = bflo(a.y) * f1 + bflo(b.y) * f2; v[8 * k + 3] = bfhi(a.y) * f1 + bfhi(b.y) * f2;
                v[8 * k + 4] = bflo(a.z) * f1 + bflo(b.z) * f2; v[8 * k + 5] = bfhi(a.z) * f1 + bfhi(b.z) * f2; v[8 * k + 6] = bflo(a.w) * f1 + bflo(b.w) * f2; v[8 * k + 7] = bfhi(a.w) * f1 + bfhi(b.w) * f2; }
        } else {
            const bf16_t* spo = (const bf16_t*)p.CACHE; const f32x2* spml = (const f32x2*)((const bf16_t*)p.CACHE + (size_t)2 * MS * MLAW); const int rs = row - MP;
#pragma unroll
            for (int k = 0; k < 2; ++k) { const int c0 = 8 * lane + 512 * k, head = c0 >> 7;
                const u32x4 a = *(const u32x4*)(spo + (size_t)rs * MLAW + c0), b = *(const u32x4*)(spo + ((size_t)MS + rs) * MLAW + c0);
                const f32x2 ml1 = spml[(size_t)rs * MH + head], ml2 = spml[((size_t)MS + rs) * MH + head];
                const float m = fmaxf(ml1.x, ml2.x); const float w1 = ml1.y * __builtin_amdgcn_exp2f(ml1.x - m), w2 = ml2.y * __builtin_amdgcn_exp2f(ml2.x - m);
                const float iw = 1.f / (w1 + w2), f1 = w1 * iw, f2 = w2 * iw;
                v[8 * k + 0] = bflo(a.x) * f1 + bflo(b.x) * f2; v[8 * k + 1] = bfhi(a.x) * f1 + bfhi(b.x) * f2; v[8 * k + 2] = bflo(a.y) * f1 + bflo(b.y) * f2; v[8 * k + 3] = bfhi(a.y) * f1 + bfhi(b.y) * f2;
                v[8 * k + 4] = bflo(a.z) * f1 + bflo(b.z) * f2; v[8 * k + 5] = bfhi(a.z) * f1 + bfhi(b.z) * f2; v[8 * k + 6] = bflo(a.w) * f1 + bflo(b.w) * f2; v[8 * k + 7] = bfhi(a.w) * f1 + bfhi(b.w) * f2; }
        }
        float s = 0.f;
#pragma unroll
        for (int j = 0; j < 16; ++j) s += v[j] * v[j];
        const float r = rsqrtf(wave_sum(s) * (1.f / MLAW) + EPS);
        const float* g = p.in[15] + 8 * lane;
#pragma unroll
        for (int j = 0; j < 16; ++j) v[j] = v[j] * r * g[(j >> 3) * 512 + (j & 7)];
        *(u32x4*)base = (u32x4){pk2(v[0], v[1]), pk2(v[2], v[3]), pk2(v[4], v[5]), pk2(v[6], v[7])};
        *(u32x4*)(base + 512) = (u32x4){pk2(v[8], v[9]), pk2(v[10], v[11]), pk2(v[12], v[13]), pk2(v[14], v[15])};
    }
}
template <int L> __device__ __forceinline__ void ret_stepC_lds(const Prm& p, LAS unsigned char* lds, int cid, int hp, int lane, int wave) {
    asm volatile("" : "+v"(lane));
    constexpr int NLB = L / 16, NH = 8 / NLB, PR = 128 / NH, NP = 256 / PR, VPP = PR / 16, RPI = PR / 16;
    const int fr = lane & 15, fq = lane >> 4, tid = wave * 64 + lane;
    const int lb = wave % NLB, hw = wave / NLB, h = (L == 64 ? 2 * hp : 0) + hw;
    const int row0 = (L == 64) ? cid * 64 : MP + (cid - 128) * 32, row = row0 + 16 * lb + fr;
    const bf16_t* Sp2 = (L == 64) ? p.SPREV + (size_t)(cid * 4 + 2 * hp) * 65536 : p.S0T + (size_t)((cid - 128) * 4) * 65536;
    bf16x8 qf[8];
    { const bf16_t* qp = p.RQ + (size_t)row * RW + h * 256 + 8 * fq;
#pragma unroll
      for (int ks = 0; ks < 8; ++ks) qf[ks] = *(const bf16x8*)(qp + 32 * ks); }
    const float inner = __builtin_amdgcn_exp2f((float)(16 * lb + fr + 1) * lg2gamma(h));
    f32x4 o[16]; float sum = 0.f;
    const float* oin = p.OINTRA + (size_t)row * RW + h * 256 + 4 * fq;
    u32x4 st[8];
    const bf16_t* sg = Sp2 + (size_t)(tid >> 5) * 256 + (tid & 31) * 8;
#define SC_LOAD(k) do { _Pragma("unroll") for (int i = 0; i < 8; ++i) st[i] = *(const u32x4*)(sg + (size_t)(i / RPI) * 65536 + (size_t)(PR * (k) + 16 * (i % RPI)) * 256); } while (0)
#define SC_STORE(b) do { LAS bf16_t* sb_ = (LAS bf16_t*)(lds + (b) * 67584) + (tid >> 5) * 264 + (tid & 31) * 8; _Pragma("unroll") for (int i = 0; i < 8; ++i) *(LAS u32x4*)(sb_ + ((i / RPI) * PR + 16 * (i % RPI)) * 264) = st[i]; } while (0)
    __syncthreads();
    SC_LOAD(0); SC_STORE(0); LDS_WAIT(); __syncthreads();
#pragma unroll
    for (int k = 0; k < NP; ++k) {
        if (k < NP - 1) SC_LOAD(k + 1);
        f32x4 it[VPP];
#pragma unroll
        for (int j = 0; j < VPP; ++j) it[j] = *(const f32x4*)(oin + 16 * (VPP * k + j));
        __builtin_amdgcn_sched_barrier(0);
        const LAS bf16_t* sb = (const LAS bf16_t*)(lds + (k & 1) * 67584) + (hw * PR + fr) * 264 + 8 * fq;
#pragma unroll
        for (int j = 0; j < VPP; ++j) { const int vb = VPP * k + j; f32x4 a = {0.f, 0.f, 0.f, 0.f};
#pragma unroll
            for (int ks = 0; ks < 8; ++ks) a = mfma16(*(const LAS bf16x8*)(sb + 16 * j * 264 + 32 * ks), qf[ks], a);
            o[vb] = a * inner + it[j]; sum += (o[vb][0] + o[vb][1]) + (o[vb][2] + o[vb][3]); }
        if (k < NP - 1) { SC_STORE((k + 1) & 1); LDS_WAIT(); }
        __syncthreads();
    }
#undef SC_LOAD
#undef SC_STORE
    sum += __shfl_xor(sum, 16); sum += __shfl_xor(sum, 32);
    const float mu = sum * (1.f / 256.f); float vs = 0.f;
#pragma unroll
    for (int vb = 0; vb < 16; ++vb) { o[vb] = o[vb] - mu; vs += (o[vb][0] * o[vb][0] + o[vb][1] * o[vb][1]) + (o[vb][2] * o[vb][2] + o[vb][3] * o[vb][3]); }
    vs += __shfl_xor(vs, 16); vs += __shfl_xor(vs, 32);
    const float rstd = rsqrtf(vs * (1.f / 256.f) + EPS);
#pragma unroll
    for (int vb = 0; vb < 16; ++vb) {
        const int col = h * 256 + 16 * vb + 4 * fq;
        const f32x4 g = *(const f32x4*)(p.in[14] + col); const u32x2 rgw = *(const u32x2*)(p.RG + (size_t)row * RW + col);
        const float y0 = o[vb][0] * rstd * g[0] * silu_f(bflo(rgw.x)), y1 = o[vb][1] * rstd * g[1] * silu_f(bfhi(rgw.x));
        const float y2 = o[vb][2] * rstd * g[2] * silu_f(bflo(rgw.y)), y3 = o[vb][3] * rstd * g[3] * silu_f(bfhi(rgw.y));
        *(u32x2*)(p.ACat + (size_t)row * DM + col) = (u32x2){pk2(y0, y1), pk2(y2, y3)};
    }
}
__device__ __forceinline__ void phase4(const Prm& p, LAS unsigned char* lds, int tid, int lane, int wave) {
    const int G = (int)gridDim.x, c = (int)blockIdx.x;
    { int t2 = lane_id(); asm volatile("" : "+v"(t2)); lane = t2; }
    const bool rows_first = G != 256 || ((c >> 5) & 1) == 0;
    if (rows_first) { if (G == 256) { if (c >= 32) mla_norm_pass(p, lane, wave, (c - 32) * NWAVES + wave, (G - 32) * NWAVES); } else mla_norm_pass(p, lane, wave, c * NWAVES + wave, G * NWAVES); }
    for (int u = c; u < 256 + 32; u += G) {
        if (u < 256) ret_stepC_lds<64>(p, lds, u >> 1, u & 1, lane, wave); else ret_stepC_lds<32>(p, lds, 128 + (u - 256), 0, lane, wave);
    }
    if (!rows_first) { int t3 = lane_id(); asm volatile("" : "+v"(t3)); mla_norm_pass(p, t3, wave, (c - 32) * NWAVES + wave, (G - 32) * NWAVES); }
}

template <int NB = 2> struct EpiH1T {
    static constexpr bool PERM = true, AFTER_DRAIN = false;
    Prm p;
    __device__ __forceinline__ void operator()(const f32x4 (&acc)[2][2][4][2], const pg8::Unit& u, int wr, int wc, int fr, int fq) const {
        const int ci = u.pn * 256 + 32 * wc + 8 * fq;
        f32x4 gg[2][2];
#pragma unroll
        for (int bj = 0; bj < 2; ++bj) { gg[bj][0] = *(const f32x4*)(p.in[17] + 128 * bj + ci); gg[bj][1] = *(const f32x4*)(p.in[17] + 128 * bj + ci + 4); }
#pragma unroll
        for (int am = 0; am < 8 / NB; ++am) { const int ai = (am * NB) >> 2;
            f32x4 xv[NB][2][2];
#pragma unroll
            for (int mm = 0; mm < NB; ++mm) { const float* xr = xrow(p, u.pm * 256 + ai * 128 + wr * 64 + (((am * NB) & 3) + mm) * 16 + fr);
#pragma unroll
                for (int bj = 0; bj < 2; ++bj) { xv[mm][bj][0] = *(const f32x4*)(xr + 128 * bj + ci); xv[mm][bj][1] = *(const f32x4*)(xr + 128 * bj + ci + 4); } }
            __builtin_amdgcn_sched_barrier(0);
#pragma unroll
            for (int mm = 0; mm < NB; ++mm) { const int m = ((am * NB) & 3) + mm;
                const int row = u.pm * 256 + ai * 128 + wr * 64 + m * 16 + fr; float s = 0.f;
#pragma unroll
                for (int bj = 0; bj < 2; ++bj) { const int col = 128 * bj + ci;
                    const f32x4 a = acc[ai][bj][m][0] + xv[mm][bj][0], b = acc[ai][bj][m][1] + xv[mm][bj][1];
                    *(f32x4*)(p.H1 + (size_t)row * DM + col) = a; *(f32x4*)(p.H1 + (size_t)row * DM + col + 4) = b;
                    s += (a[0] * a[0] + a[1] * a[1]) + (a[2] * a[2] + a[3] * a[3]) + (b[0] * b[0] + b[1] * b[1]) + (b[2] * b[2] + b[3] * b[3]);
                    const f32x4 g0 = gg[bj][0], g1 = gg[bj][1];
                    *(u32x4*)(p.XN + (size_t)row * DM + col) = (u32x4){pk2(a[0] * g0[0], a[1] * g0[1]), pk2(a[2] * g0[2], a[3] * g0[3]), pk2(b[0] * g1[0], b[1] * g1[1]), pk2(b[2] * g1[2], b[3] * g1[3])}; }
                s += __shfl_xor(s, 16); s += __shfl_xor(s, 32); if (fq == 0) p.ssq2[(size_t)row * 32 + u.pn * 4 + wc] = s;
            }
        }
    }
};
typedef EpiH1T<2> EpiH1;
__device__ __forceinline__ float row_rs32(const float* ssq, int row) {
    const f32x4* q = (const f32x4*)(ssq + (size_t)row * 32); float s = 0.f;
#pragma unroll
    for (int j = 0; j < 8; ++j) { const f32x4 v = q[j]; s += (v.x + v.y) + (v.z + v.w); }
    return rsqrtf(s * (1.f / DM) + EPS);
}
struct EpiSC {
    static constexpr bool PERM = true, AFTER_DRAIN = false;
    Prm p;
    __device__ __forceinline__ void operator()(const f32x4 (&acc)[2][2][4][2], const pg8::Unit& u, int wr, int wc, int fr, int fq) const {
        const int ci = u.pn * 256 + 32 * wc + 8 * fq;
        float rr[2][4];
#pragma unroll
        for (int ai = 0; ai < 2; ++ai)
#pragma unroll
            for (int m = 0; m < 4; ++m) rr[ai][m] = row_rs32(p.ssq2, u.pm * 256 + ai * 128 + wr * 64 + m * 16 + fr);
#pragma unroll
        for (int ai = 0; ai < 2; ++ai)
#pragma unroll
            for (int m = 0; m < 4; ++m) {
                const int row = u.pm * 256 + ai * 128 + wr * 64 + m * 16 + fr; const float r = rr[ai][m];
#pragma unroll
                for (int bj = 0; bj < 2; ++bj) { float* d = p.SC + (size_t)row * DM + 128 * bj + ci; *(f32x4*)d = acc[ai][bj][m][0] * r; *(f32x4*)(d + 4) = acc[ai][bj][m][1] * r; }
            }
    }
};
struct EpiGate {
    static constexpr bool PERM = true, AFTER_DRAIN = false;
    Prm p;
    __device__ __forceinline__ void operator()(const f32x4 (&acc)[2][2][4][2], const pg8::Unit& u, int wr, int wc, int fr, int fq) const {
        const int ci = u.pn * 256 + 32 * wc + 8 * fq;
#pragma unroll
        for (int am = 0; am < 4; ++am) { const int ai = am >> 1;
            f32x4 hv[2][2][2]; u32x4 pv[2][2];
#pragma unroll
            for (int mm = 0; mm < 2; ++mm) { const size_t ro = (size_t)(u.pm * 256 + ai * 128 + wr * 64 + (2 * (am & 1) + mm) * 16 + fr) * DM;
#pragma unroll
                for (int bj = 0; bj < 2; ++bj) { const int col = 128 * bj + ci; hv[mm][bj][0] = *(const f32x4*)(p.H1 + ro + col); hv[mm][bj][1] = *(const f32x4*)(p.H1 + ro + col + 4); pv[mm][bj] = *(const u32x4*)(p.PP + ro + col); } }
            __builtin_amdgcn_sched_barrier(0);
#pragma unroll
            for (int mm = 0; mm < 2; ++mm) { const int m = 2 * (am & 1) + mm;
                const int row = u.pm * 256 + ai * 128 + wr * 64 + m * 16 + fr; float s = 0.f;
#pragma unroll
                for (int bj = 0; bj < 2; ++bj) { const int col = 128 * bj + ci;
                    const u32x4 pw = pv[mm][bj];
                    const float pp[8] = {bflo(pw.x), bfhi(pw.x), bflo(pw.y), bfhi(pw.y), bflo(pw.z), bfhi(pw.z), bflo(pw.w), bfhi(pw.w)};
                    f32x4 a = hv[mm][bj][0], b = hv[mm][bj][1];
#pragma unroll
                    for (int e = 0; e < 4; ++e) { a[e] += pp[e] / (1.f + __expf(-acc[ai][bj][m][0][e])); b[e] += pp[4 + e] / (1.f + __expf(-acc[ai][bj][m][1][e])); }
                    *(f32x4*)(p.out + O_Y + (size_t)row * DM + col) = a; *(f32x4*)(p.out + O_Y + (size_t)row * DM + col + 4) = b;
                    s += (a[0] * a[0] + a[1] * a[1]) + (a[2] * a[2] + a[3] * a[3]) + (b[0] * b[0] + b[1] * b[1]) + (b[2] * b[2] + b[3] * b[3]); }
                s += __shfl_xor(s, 16); s += __shfl_xor(s, 32); if (fq == 0) p.ssq3[(size_t)row * 32 + u.pn * 4 + wc] = s;
            }
        }
    }
};
struct EpiGateH {
    static constexpr bool PERM = true, AFTER_DRAIN = false;
    Prm p;
    __device__ __forceinline__ void operator()(const f32x4 (&acc)[2][2][4][2], const pg8::Unit& u, int wr, int wc, int fr, int fq) const {
        const int ci = u.pn * 256 + 32 * wc + 8 * fq;
#pragma unroll
        for (int am = 0; am < 2; ++am) { const int ai = 0;
            f32x4 hv[2][2][2]; u32x4 pv[2][2];
#pragma unroll
            for (int mm = 0; mm < 2; ++mm) { const size_t ro = (size_t)(u.pm * 128 + wr * 64 + (2 * (am & 1) + mm) * 16 + fr) * DM;
#pragma unroll
                for (int bj = 0; bj < 2; ++bj) { const int col = 128 * bj + ci; hv[mm][bj][0] = *(const f32x4*)(p.H1 + ro + col); hv[mm][bj][1] = *(const f32x4*)(p.H1 + ro + col + 4); pv[mm][bj] = *(const u32x4*)(p.PP + ro + col); } }
            __builtin_amdgcn_sched_barrier(0);
#pragma unroll
            for (int mm = 0; mm < 2; ++mm) { const int m = 2 * (am & 1) + mm;
                const int row = u.pm * 128 + wr * 64 + m * 16 + fr; float s = 0.f;
#pragma unroll
                for (int bj = 0; bj < 2; ++bj) { const int col = 128 * bj + ci;
                    const u32x4 pw = pv[mm][bj];
                    const float pp[8] = {bflo(pw.x), bfhi(pw.x), bflo(pw.y), bfhi(pw.y), bflo(pw.z), bfhi(pw.z), bflo(pw.w), bfhi(pw.w)};
                    f32x4 a = hv[mm][bj][0], b = hv[mm][bj][1];
#pragma unroll
                    for (int e = 0; e < 4; ++e) { a[e] += pp[e] / (1.f + __expf(-acc[ai][bj][m][0][e])); b[e] += pp[4 + e] / (1.f + __expf(-acc[ai][bj][m][1][e])); }
                    *(f32x4*)(p.out + O_Y + (size_t)row * DM + col) = a; *(f32x4*)(p.out + O_Y + (size_t)row * DM + col + 4) = b;
                    s += (a[0] * a[0] + a[1] * a[1]) + (a[2] * a[2] + a[3] * a[3]) + (b[0] * b[0] + b[1] * b[1]) + (b[2] * b[2] + b[3] * b[3]); }
                s += __shfl_xor(s, 16); s += __shfl_xor(s, 32); if (fq == 0) p.ssq3[(size_t)row * 32 + u.pn * 4 + wc] = s;
            }
        }
    }
};
struct RangeOrder {
    int nM, nN, nwg, G, c, L0, L1, pm_off, wv = 0;
    __device__ __forceinline__ void init(int M, int N, int G_, int c_, int L0_, int L1_, int pm_off_) { nM = M / pg8::BM; nN = N / pg8::BM; nwg = nM * nN; G = G_; c = c_; L0 = L0_; L1 = L1_; pm_off = pm_off_; }
    __device__ __forceinline__ bool next(int i, pg8::Unit& u) const {
        const long L = (long)L0 + (long)i * G + c; if (c < 0 || c >= G || L >= L1) return false;
        int wgid = (int)L; { const int q = nwg / pg8::NXCD, r = nwg % pg8::NXCD, xcd = wgid % pg8::NXCD, off = wgid / pg8::NXCD; wgid = (xcd < r ? xcd * (q + 1) : r * (q + 1) + (xcd - r) * q) + off; }
        const int nig = pg8::WGM * nN, gid = wgid / nig, fm = gid * pg8::WGM, gsz = (nM - fm) < pg8::WGM ? (nM - fm) : pg8::WGM;
        u.pm = fm + ((wgid % nig) % gsz) + pm_off; u.pn = (wgid % nig) / gsz; return true;
    }
    __device__ __forceinline__ void a_ready(const pg8::Unit&) const {}
    __device__ __forceinline__ void done(const pg8::Unit&) const {}
};
template <class Epi> __device__ __forceinline__ void gemm_range(const Prm& p, LAS unsigned char* lds, const bf16_t* A, const bf16_t* Bt, const Epi& E, int Msub, int G, int c, int L0, int L1, int pm_off, int wave) {
    pg8::Gemm g{A, Bt, MT, DM, DM}; RangeOrder S; S.init(Msub, DM, G, c, L0, L1, pm_off); S.wv = wave;
    pg8::gemm_phase<Epi, RangeOrder, true, true>(lds, g, S, E);
}
__device__ __forceinline__ void final_norm_rows(const Prm& p, int row0, int row1, int gw, int NGW, int lane) {
    for (int row = row0 + gw; row < row1; row += NGW) {
        const float r = row_rs32(p.ssq3, row);
        f32x4* y = (f32x4*)(p.out + O_Y + (size_t)row * DM) + lane; const f32x4* g = (const f32x4*)p.in[25] + lane;
#pragma unroll
        for (int j = 0; j < 8; ++j) { const f32x4 v = y[64 * j], gg = g[64 * j]; __builtin_nontemporal_store((f32x4){v.x * r * gg.x, v.y * r * gg.y, v.z * r * gg.z, v.w * r * gg.w}, &y[64 * j]); }
    }
}
__device__ __forceinline__ void phase5a(const Prm& p, LAS unsigned char* lds, int tid, int lane, int wave) {
    EpiH1 E{p}; gemm_range<EpiH1>(p, lds, p.ACat, p.WoutT, E, MP, (int)gridDim.x, (int)blockIdx.x, 0, 256, 0, wave);
}
__device__ __forceinline__ void phase5b(const Prm& p, LAS unsigned char* lds, int tid, int lane, int wave) {
    int c = (int)blockIdx.x; asm volatile("" : "+s"(c)); const int G = (int)gridDim.x;
    if (c < 32) { EpiH1T<1> E{p}; gemm_range<EpiH1T<1>>(p, lds, p.ACat, p.WoutT, E, MS, 32, c, 0, 32, 32, wave); }
    else { EpiSC E{p}; gemm_range<EpiSC>(p, lds, p.XN, p.WsT, E, MP, G - 32, c - 32, 0, G - 32, 0, wave); }
}
__device__ __forceinline__ void phase6c(const Prm& p, LAS unsigned char* lds, int tid, int lane, int wave) {
    int c = (int)blockIdx.x; asm volatile("" : "+s"(c)); const int G = (int)gridDim.x;
    if (c < 32) { EpiSC E{p}; gemm_range<EpiSC>(p, lds, p.XN, p.WsT, E, MP, 32, c, G - 32, 256, 0, wave); }
    else if (c < 64) { EpiSC E{p}; gemm_range<EpiSC>(p, lds, p.XN, p.WsT, E, MS, 32, c - 32, 0, 32, 32, wave); }
    else {
        { int t2 = lane_id(); asm volatile("" : "+v"(t2)); expert_tables_fp8(p, (c - 64) * NWAVES + wave, (G - 64) * NWAVES, t2); }
        int kk = PLE; asm volatile("" : "+s"(kk));
        pg8::Gemm g2{p.Pb, p.WpT, MT, DM, kk}; pg8::StaticOrder S2; S2.init(MT, DM, G - 64, c - 64); S2.wv = wave; EpiPP E2{p.PP, DM}; pg8::gemm_phase<EpiPP, pg8::StaticOrder, true, true>(lds, g2, S2, E2);
    }
}
__device__ __forceinline__ void phase8a(const Prm& p, LAS unsigned char* lds, int tid, int lane, int wave) {
    EpiGate E{p}; gemm_range<EpiGate>(p, lds, p.XN, p.WgT, E, MP, (int)gridDim.x, (int)blockIdx.x, 0, 256, 0, wave);
}
struct HalfOrder {
    int c, wv = 0;
    __device__ __forceinline__ bool next(int i, pg8::Unit& u) const { if (i != 0 || c < 0 || c >= 64) return false; u.pm = MP / 128 + (c & 7); u.pn = c >> 3; return true; }
    __device__ __forceinline__ void a_ready(const pg8::Unit&) const {}
    __device__ __forceinline__ void done(const pg8::Unit&) const {}
};
__device__ __forceinline__ void phase8b(const Prm& p, LAS unsigned char* lds, int tid, int lane, int wave) {
    const int c = (int)blockIdx.x, G = (int)gridDim.x;
    if (c < 64) { EpiGateH E{p}; pg8::Gemm g{p.XN, p.WgT, MT, DM, DM}; HalfOrder S; S.c = c; S.wv = wave;
        pg8::gemm_phase<EpiGateH, HalfOrder, true, true, true>(lds, g, S, E); }
    else { int t2 = lane_id(); asm volatile("" : "+v"(t2)); final_norm_rows(p, 0, MP, (c - 64) * NWAVES + wave, (G - 64) * NWAVES, t2); }
}
__device__ __forceinline__ void phase9s(const Prm& p, LAS unsigned char* lds, int tid, int lane, int wave) {
    final_norm_rows(p, MP, MT, (int)blockIdx.x * NWAVES + wave, (int)gridDim.x * NWAVES, lane);
}

typedef __bf16 v2bf __attribute__((ext_vector_type(2)));
__device__ __forceinline__ float dot2bf(unsigned a, unsigned b, float c) { return __builtin_amdgcn_fdot2_f32_bf16(__builtin_bit_cast(v2bf, a), __builtin_bit_cast(v2bf, b), c, false); }
__device__ __forceinline__ unsigned sortkey(float f, unsigned idx) { unsigned u = __float_as_uint(f); u = (u & 0x80000000u) ? ~u : (u | 0x80000000u); return (u & ~127u) | (127u - idx); }
__device__ __forceinline__ float gelu_erf(float v) {
    const float av = fabsf(v), t = __builtin_amdgcn_rcpf(av * 0.2316418882f + 1.0f);
    float q = t * 0.5307027145f + (-0.7265760135f); q = q * t + 0.7107068705f; q = q * t + (-0.142248368f); q = q * t + 0.127414796f; q = q * t;
    const float e = __builtin_amdgcn_exp2f((v * v) * (-0.72134752044f)); const float m = v * (q * e);
    return v < 0.f ? m : v - m;
}

template <int PMODE = 0> __device__ __forceinline__ void phase7(const Prm& p, LAS unsigned char* lds, int tid, int lane, int wave) {
    constexpr bool COMMIT = PMODE == 0;
    constexpr int PAIRSZ = 30720, SLOT0 = 1152, SLOTSZ = 6400, OB0 = SLOT0 + 2 * SLOTSZ, OBSZ = 8192;
    const int pr = wave & 3; const bool producer = wave < 4;
    const int gp = blockIdx.x * 4 + pr, NGP = gridDim.x * 4;
    const int ntot = (MT - gp + NGP - 1) / NGP;
    LAS unsigned char* pb = lds + pr * PAIRSZ;
    LAS unsigned* wl = (LAS unsigned*)pb;
    LAS unsigned* skey = wl;
    LAS float* tv = (LAS float*)(wl + 128);
    LAS int* ti = (LAS int*)(wl + 160);
    LAS unsigned* ckey = wl + 192;
    LAS volatile unsigned* flg = (LAS volatile unsigned*)(pb + 1024);
    if (producer && lane == 0) { flg[0] = 0u; flg[1] = 0u; flg[2] = 0u; flg[3] = 0u; }
    __syncthreads();
    if (producer) {
    int ca = 0, cb = 0; const bool cvalid = lane < 50;
    { int base = 0; bool found = false;
#pragma unroll
      for (int a = 0; a < 16; ++a) { const int nb = 16 / (a + 1); if (!found && lane < base + nb) { ca = a; cb = lane - base; found = true; } base += nb; } }
    if (!cvalid) { ca = 0; cb = 0; }
    int epi = 0;
    for (int nt = 0; nt <= ntot; ++nt) {
        const int row = gp + nt * NGP; const bool live = nt < ntot;
        LAS unsigned char* slot = pb + SLOT0 + (nt & 1) * SLOTSZ;
        LAS int* exi = (LAS int*)slot; LAS float* exs = (LAS float*)(slot + 544);
        float sa[16], sb[16];
        u32x4 mraw[4]; float r2 = 0.f;
        if (live) { const float* sc = p.SC + (size_t)row * DM;
#pragma unroll
            for (int g = 0; g < 16; ++g) { sa[g] = *(sc + g * 128 + lane); sb[g] = *(sc + g * 128 + 64 + lane); }
#pragma unroll
            for (int q = 0; q < 4; ++q) mraw[q] = *((const u32x4*)(p.XN + (size_t)row * DM + 32 * lane + 8 * q));
            r2 = row_rs32(p.ssq2, row); }
        for (;;) {
            const int fin = __builtin_amdgcn_readfirstlane((int)flg[2]);
            if (epi < fin) {
                asm volatile("" ::: "memory");
                const int erow = gp + epi * NGP; const LAS f32x4* ob = (const LAS f32x4*)(pb + OB0 + (epi & 1) * OBSZ);
                float ss = 0.f; f32x4 hv4[8];
#pragma unroll
                for (int q = 0; q < 8; ++q) { float* hp = p.H1 + (size_t)erow * DM + 32 * lane + 4 * q;
                    f32x4 a = *((const f32x4*)hp); const f32x4 o = ob[q * 64 + lane]; a += o; hv4[q] = a; ss += (a.x * a.x + a.y * a.y) + (a.z * a.z + a.w * a.w);
                    if (COMMIT) *(f32x4*)hp = a; }
                LDS_WAIT();
                if (lane == 0) flg[3] = (unsigned)(epi + 1);
                const float r3 = rsqrtf(wave_sum(ss) * (1.f / DM) + EPS);
#pragma unroll
                for (int q = 0; q < 4; ++q) { const float* g = p.in[22] + 32 * lane + 8 * q; const f32x4 ga = *(const f32x4*)g, gb = *(const f32x4*)(g + 4); const f32x4 x0 = hv4[2 * q], x1 = hv4[2 * q + 1];
                    u32x4* xo = COMMIT ? (u32x4*)(p.XN + (size_t)erow * DM + 32 * lane + 8 * q) : (u32x4*)p.OINTRA + (size_t)(blockIdx.x * 512 + wave * 64 + lane);
                    *xo = (u32x4){pk2(x0.x * r3 * ga[0], x0.y * r3 * ga[1]), pk2(x0.z * r3 * ga[2], x0.w * r3 * ga[3]), pk2(x1.x * r3 * gb[0], x1.y * r3 * gb[1]), pk2(x1.z * r3 * gb[2], x1.w * r3 * gb[3])}; }
                ++epi; continue;
            }
            const bool go = live ? (nt - __builtin_amdgcn_readfirstlane((int)flg[1]) < 2) : (epi >= ntot);
            if (go) break;
            __builtin_amdgcn_s_sleep(2);
        }
        if (!live) break;
        asm volatile("" ::: "memory");
        { LAS u32x4* mo = (LAS u32x4*)(slot + 2304);
#pragma unroll
          for (int q = 0; q < 4; ++q) mo[q * 64 + lane] = mraw[q];
          if (lane == 0) *(LAS float*)(slot + 2176) = r2; }
#pragma unroll
        for (int hh = 0; hh < PH; ++hh) {
            const float a0[2] = {sa[2 * hh], sa[2 * hh + 1]}, a1[2] = {sb[2 * hh], sb[2 * hh + 1]};
            const unsigned k0[2] = {sortkey(a0[0], lane), sortkey(a0[1], lane)}, k1[2] = {sortkey(a1[0], 64 + lane), sortkey(a1[1], 64 + lane)};
            unsigned T0 = 0u, T1 = 0u, bm = 0x80000000u; int n0 = 128, n1 = 128;
#pragma unroll 1
            do { const unsigned c0 = T0 | bm, c1 = T1 | bm; bm >>= 1;
                const int cnt0 = __builtin_popcountll(__builtin_amdgcn_ballot_w64(k0[0] >= c0)) + __builtin_popcountll(__builtin_amdgcn_ballot_w64(k1[0] >= c0));
                const int cnt1 = __builtin_popcountll(__builtin_amdgcn_ballot_w64(k0[1] >= c1)) + __builtin_popcountll(__builtin_amdgcn_ballot_w64(k1[1] >= c1));
                T0 = (unsigned)__builtin_amdgcn_readfirstlane((int)(cnt0 >= 16 ? c0 : T0)); n0 = __builtin_amdgcn_readfirstlane(cnt0 >= 16 ? cnt0 : n0);
                T1 = (unsigned)__builtin_amdgcn_readfirstlane((int)(cnt1 >= 16 ? c1 : T1)); n1 = __builtin_amdgcn_readfirstlane(cnt1 >= 16 ? cnt1 : n1);
            } while (n0 + n1 != 32);
#pragma unroll
            for (int half = 0; half < 2; ++half) {
                const unsigned T = half ? T1 : T0;
                const bool s0 = k0[half] >= T, s1 = k1[half] >= T;
                const unsigned long long b0 = __builtin_amdgcn_ballot_w64(s0), b1 = __builtin_amdgcn_ballot_w64(s1);
                const int below0 = __builtin_amdgcn_mbcnt_hi((unsigned)(b0 >> 32), __builtin_amdgcn_mbcnt_lo((unsigned)b0, 0u));
                const int below1 = __builtin_popcountll(b0) + __builtin_amdgcn_mbcnt_hi((unsigned)(b1 >> 32), __builtin_amdgcn_mbcnt_lo((unsigned)b1, 0u));
                LAS unsigned* sk = skey + half * 48;
                if (s0) { sk[below0] = k0[half]; sk[16 + below0] = __float_as_uint(a0[half]); sk[32 + below0] = (unsigned)lane; }
                if (s1) { sk[below1] = k1[half]; sk[16 + below1] = __float_as_uint(a1[half]); sk[32 + below1] = (unsigned)(64 + lane); }
            }
            LDS_WAIT();
            if (lane < 32) { const int half = lane >> 4, l16 = lane & 15; const LAS unsigned* sk = skey + half * 48; const unsigned mine = sk[l16]; int rk = 0;
#pragma unroll
                for (int j4 = 0; j4 < 4; ++j4) { const u32x4 v = ((const LAS u32x4*)sk)[j4]; rk += (int)(v.x > mine) + (int)(v.y > mine) + (int)(v.z > mine) + (int)(v.w > mine); }
                tv[half * 16 + rk] = __uint_as_float(sk[16 + l16]); ti[half * 16 + rk] = (int)sk[32 + l16]; }
            LDS_WAIT();
            const float cv = cvalid ? tv[ca] + tv[16 + cb] : -3.0e38f;
            const unsigned ck = sortkey(cv, lane);
            unsigned T = 0u, bmc = 0x80000000u; int cnt;
#pragma unroll 1
            do { const unsigned cand = T | bmc; bmc >>= 1; cnt = __builtin_popcountll(__builtin_amdgcn_ballot_w64(ck >= cand));
                T = (unsigned)__builtin_amdgcn_readfirstlane((int)(cnt >= 16 ? cand : T)); } while (cnt != 16);
            const bool sc_ = ck >= T;
            const unsigned long long bc = __builtin_amdgcn_ballot_w64(sc_);
            const int belowc = __builtin_amdgcn_mbcnt_hi((unsigned)(bc >> 32), __builtin_amdgcn_mbcnt_lo((unsigned)bc, 0u));
            if (sc_) { ckey[belowc] = ck; ckey[16 + belowc] = __float_as_uint(cv); ckey[32 + belowc] = (unsigned)(ti[ca] * NKEYS + ti[16 + cb]); }
            LDS_WAIT();
            if (lane < 16) { const unsigned mine = ckey[lane]; int rk = 0;
#pragma unroll
                for (int j4 = 0; j4 < 4; ++j4) { const u32x4 v = ((const LAS u32x4*)ckey)[j4]; rk += (int)(v.x > mine) + (int)(v.y > mine) + (int)(v.z > mine) + (int)(v.w > mine); }
                exi[hh * 16 + rk] = (int)ckey[32 + lane]; exs[hh * 16 + rk] = __uint_as_float(ckey[16 + lane]); }
            LDS_WAIT();
        }
        { LAS float* wt = (LAS float*)skey;
          const float s0 = exs[lane], s1 = exs[64 + lane], m0 = exs[lane & ~15], m1 = exs[64 + (lane & ~15)];
          const float w0 = __expf(s0 - m0), w1 = __expf(s1 - m1);
          wt[lane] = w0; wt[64 + lane] = w1; LDS_WAIT();
          float t0 = 0.f, t1 = 0.f;
#pragma unroll
          for (int j = 0; j < 4; ++j) { const f32x4 a = ((const LAS f32x4*)wt)[(lane >> 4) * 4 + j], b = ((const LAS f32x4*)wt)[16 + (lane >> 4) * 4 + j];
              t0 += (a.x + a.y) + (a.z + a.w); t1 += (b.x + b.y) + (b.z + b.w); }
          exs[lane] = w0 / t0; exs[64 + lane] = w1 / t1; LDS_WAIT(); }
        { const int i0 = exi[lane], i1 = exi[64 + lane]; LAS float* exu = (LAS float*)(slot + 1088); LAS float* exv = (LAS float*)(slot + 1632);
          exu[lane] = p.US[i0]; exu[64 + lane] = p.US[i1]; exv[lane] = p.VS[i0]; exv[64 + lane] = p.VS[i1]; LDS_WAIT(); }
        if (lane == 0) flg[0] = (unsigned)(nt + 1);
    }
    } else {
    int lq = lane >> 2; asm volatile("" : "+v"(lq)); const bool lb0 = (lane & 1) != 0, lb1 = (lane & 2) != 0;
    for (int nt = 0; nt < ntot; ++nt) {
        LAS unsigned char* slot = pb + SLOT0 + (nt & 1) * SLOTSZ;
        while ((int)__builtin_amdgcn_readfirstlane((int)flg[0]) <= nt) __builtin_amdgcn_s_sleep(2);
        asm volatile("" ::: "memory");
        const int idA = ((const LAS int*)slot)[lane], idB = ((const LAS int*)slot)[64 + lane];
        const float gA = ((const LAS float*)(slot + 544))[lane], gB = ((const LAS float*)(slot + 544))[64 + lane];
        const float usA = ((const LAS float*)(slot + 1088))[lane], usB = ((const LAS float*)(slot + 1088))[64 + lane], vsA = ((const LAS float*)(slot + 1632))[lane], vsB = ((const LAS float*)(slot + 1632))[64 + lane];
        const float r2 = *(const LAS float*)(slot + 2176);
        f32x2 mf[16];
#pragma unroll
        for (int q = 0; q < 4; ++q) { const u32x4 w = ((const LAS u32x4*)(slot + 2304))[q * 64 + lane];
            mf[4 * q + 0] = (f32x2){bflo(w.x), bfhi(w.x)}; mf[4 * q + 1] = (f32x2){bflo(w.y), bfhi(w.y)}; mf[4 * q + 2] = (f32x2){bflo(w.z), bfhi(w.z)}; mf[4 * q + 3] = (f32x2){bflo(w.w), bfhi(w.w)}; }
        LDS_WAIT();
        if (lane == 0) flg[1] = (unsigned)(nt + 1);
        unsigned lo16 = (unsigned)lane * 16u; asm volatile("" : "+v"(lo16));
        u32x4 rb[4][4];
#define ROW_LD(dst, tab, id) do { const unsigned char* rp_ = (tab) + (size_t)((unsigned)(id) * (unsigned)EROW); dst = *(const u32x4*)(rp_ + lo16); } while (0)
#define GRP_LD(buf, tab, idv, i0) do { _Pragma("unroll") for (int x = 0; x < 4; ++x) ROW_LD(rb[buf][x], tab, __builtin_amdgcn_readlane(idv, (i0) + x)); __builtin_amdgcn_sched_barrier(0); } while (0)
#define FP4X2(w, b) __builtin_amdgcn_cvt_scalef32_pk_f32_fp4(w, 1.0f, b)
#define U_PROC(buf, i0) do { float d_[4]; \
            _Pragma("unroll") for (int x = 0; x < 4; ++x) { const u32x4 r_ = rb[buf][x]; f32x2 c0 = {0.f, 0.f}, c1 = {0.f, 0.f}; \
                _Pragma("unroll") for (int d = 0; d < 4; ++d) { c0 = __builtin_elementwise_fma(FP4X2(r_[d], 0), mf[4 * d], c0); c1 = __builtin_elementwise_fma(FP4X2(r_[d], 1), mf[4 * d + 1], c1); \
                    c0 = __builtin_elementwise_fma(FP4X2(r_[d], 2), mf[4 * d + 2], c0); c1 = __builtin_elementwise_fma(FP4X2(r_[d], 3), mf[4 * d + 3], c1); } \
                c0 += c1; d_[x] = c0.x + c0.y; } \
            const float t_ = quad4_total(d_[0], d_[1], d_[2], d_[3], lb0, lb1); h = (lq == ((i0) >> 2)) ? t_ : h; \
            __builtin_amdgcn_sched_barrier(0); } while (0)
#define V_PROC(buf, i0) do { _Pragma("unroll") for (int x = 0; x < 4; ++x) { const float c_ = __builtin_bit_cast(float, __builtin_amdgcn_readlane(__builtin_bit_cast(int, cc), (i0) + x)); \
                const u32x4 r_ = rb[buf][x]; const f32x2 c2 = {c_, c_}; \
                _Pragma("unroll") for (int d = 0; d < 4; ++d) { oacc[4 * d] = __builtin_elementwise_fma(FP4X2(r_[d], 0), c2, oacc[4 * d]); oacc[4 * d + 1] = __builtin_elementwise_fma(FP4X2(r_[d], 1), c2, oacc[4 * d + 1]); \
                    oacc[4 * d + 2] = __builtin_elementwise_fma(FP4X2(r_[d], 2), c2, oacc[4 * d + 2]); oacc[4 * d + 3] = __builtin_elementwise_fma(FP4X2(r_[d], 3), c2, oacc[4 * d + 3]); } } \
            __builtin_amdgcn_sched_barrier(0); } while (0)
        float hv[2];
        if (PMODE != 4) { GRP_LD(0, p.U8, idA, 0); GRP_LD(1, p.U8, idA, 4); }
#pragma unroll
        for (int hf = 0; hf < 2; ++hf) {
            const int idc = hf ? idB : idA, idn = hf ? idA : idB; const unsigned char* tn = hf ? p.V8 : p.U8;
            float h = 0.f;
#pragma unroll 1
            for (int gl = 0; gl < (PMODE == 4 ? 0 : 16); gl += 4) {
#pragma unroll
                for (int k = 0; k < 4; ++k) {
                    { const int G = gl + k + 2; const bool nx = G >= 16; const int idv = nx ? idn : idc; const unsigned char* tb = nx ? tn : p.U8; GRP_LD((k + 2) & 3, tb, idv, (G & 15) * 4); }
                    U_PROC(k, (gl + k) * 4);
                }
            }
            hv[hf] = h;
        }
        const float cA = gA * gelu_erf(hv[0] * r2 * usA) * vsA, cB = gB * gelu_erf(hv[1] * r2 * usB) * vsB;
        f32x2 oacc[16];
#pragma unroll
        for (int j = 0; j < 16; ++j) oacc[j] = (f32x2){0.f, 0.f};
#pragma unroll
        for (int hf = 0; hf < 2; ++hf) {
            const int idc = hf ? idB : idA; const float cc = hf ? cB : cA;
#pragma unroll 1
            for (int gl = 0; gl < (PMODE == 4 ? 0 : 16); gl += 4) {
#pragma unroll
                for (int k = 0; k < 4; ++k) {
                    { const int G = gl + k + 2; const bool nx = G >= 16; if (hf == 0 || !nx) { const int idv = nx ? idB : idc; GRP_LD((k + 2) & 3, p.V8, idv, (G & 15) * 4); } }
                    V_PROC(k, (gl + k) * 4);
                }
            }
        }
#undef ROW_LD
#undef GRP_LD
#undef U_PROC
#undef V_PROC
#undef FP4X2
        while (nt - (int)__builtin_amdgcn_readfirstlane((int)flg[3]) >= 2) __builtin_amdgcn_s_sleep(2);
        asm volatile("" ::: "memory");
        { LAS f32x4* ob = (LAS f32x4*)(pb + OB0 + (nt & 1) * OBSZ);
#pragma unroll
          for (int q = 0; q < 8; ++q) ob[q * 64 + lane] = (f32x4){oacc[2 * q].x, oacc[2 * q].y, oacc[2 * q + 1].x, oacc[2 * q + 1].y};
          LDS_WAIT(); }
        if (lane == 0) flg[2] = (unsigned)(nt + 1);
    }
    }
}

#ifndef MK_LAST_PHASE
#define MK_LAST_PHASE 99
#endif

struct KArgs { const float* in[26]; float* out; unsigned char* ws; };
constexpr size_t al256(size_t x) { return (x + 255) & ~(size_t)255; }
#define WS_LIST(X) \
    X(CTL, unsigned, 16384) \
    X(WinT, bf16_t, (size_t)INWP * DM * 2) X(WuqT, bf16_t, 1536 * 512 * 2) X(WukT, bf16_t, 1024 * 512 * 2) X(WuvTg, bf16_t, 1024 * 512 * 2) X(WuvT, bf16_t, 1024 * 512 * 2) X(WukN, bf16_t, 512 * 1024 * 2) \
    X(WoutT, bf16_t, (size_t)DM * DM * 2) X(WsT, bf16_t, (size_t)DM * DM * 2) X(WgT, bf16_t, (size_t)DM * DM * 2) X(WpT, bf16_t, (size_t)DM * PLE * 2) X(U8, unsigned char, (size_t)NEXP * DM) X(V8, unsigned char, (size_t)NEXP * DM) X(US, float, (size_t)NEXP * 4) X(VS, float, (size_t)NEXP * 4) \
    X(tabR, f32x2, (size_t)SEQ * 128 * 8) X(tab64, f32x2, (size_t)SEQ * 32 * 8) X(XN, bf16_t, (size_t)MT * DM * 2) X(Pb, bf16_t, (size_t)MT * PLE * 2) \
    X(RQ, bf16_t, (size_t)MT * RW * 2) X(RK, bf16_t, (size_t)MT * RW * 2) X(RKt, bf16_t, (size_t)MT * RW * 2) X(RVt, bf16_t, (size_t)MT * RW * 2) X(RG, bf16_t, (size_t)MT * RW * 2) \
    X(ZCQ, bf16_t, (size_t)MT * 512 * 2) X(ZCKV, bf16_t, (size_t)MT * 512 * 2) X(KRb, bf16_t, (size_t)MT * 64 * 2) X(CKVNs, bf16_t, (size_t)MS * 512 * 2) \
    X(Q, bf16_t, (size_t)MT * 1536 * 2) X(KN, bf16_t, (size_t)MP * 1024 * 2) X(VTp, bf16_t, (size_t)1024 * MP * 2) X(PP, bf16_t, (size_t)MT * DM * 2) \
    X(CACHE, bf16_t, (size_t)DECB * PAST * CROW * 2) X(S0T, bf16_t, (size_t)128 * 65536 * 2) X(SPREV, bf16_t, (size_t)512 * 65536 * 2) X(ACat, bf16_t, (size_t)MT * DM * 2) X(PARTO, bf16_t, (size_t)2 * MP * MLAW * 2) X(PARTML, f32x2, (size_t)2 * MP * MH * 8) \
    X(ssq1, float, (size_t)MT * 16 * 4) X(OINTRA, float, (size_t)MT * RW * 4) X(KVp, float, (size_t)512 * 65536 * 4) X(H1, float, (size_t)MT * DM * 4) X(ssq2, float, (size_t)MT * 32 * 4) X(ssq3, float, (size_t)MT * 32 * 4)
struct WsOff {
#define X(name, T, bytes) size_t name;
    WS_LIST(X)
#undef X
    size_t total;
};
constexpr WsOff make_wsoff() { WsOff o{}; size_t off = 0;
#define X(name, T, bytes) o.name = off; off += al256(bytes);
    WS_LIST(X)
#undef X
    o.total = off; return o; }
constexpr WsOff WSO = make_wsoff();
__device__ __forceinline__ Prm make_prm(const KArgs& a) { Prm p;
#pragma unroll
    for (int i = 0; i < 26; ++i) p.in[i] = a.in[i];
    p.out = a.out;
#define X(name, T, bytes) p.name = (T*)(a.ws + WSO.name);
    WS_LIST(X)
#undef X
    p.SC = p.KVp; return p; }

__device__ __forceinline__ void dbg_fill(const Prm& p, int last, const XcdBarrier& xb, int tid0) {
    xcd_barrier(xb);
    const long gt = (long)blockIdx.x * NTHR + tid0, NGT = (long)gridDim.x * NTHR;
    for (long i = gt; i < (long)MT * DM; i += NGT) {
        float v = 0.f;
        if (last == 3 || last == 4) v = bf2f(p.ACat[i]);
        else if (last == 5 || last == 7) v = p.H1[i];
        else if (last == 6) v = p.SC[i];
        else if (last == 8) v = p.out[O_Y + i];
        if (!(fabsf(v) < 1e30f)) v = 12345.f;
        p.out[O_Y + i] = v;
    }
    if (last < 3) for (long i = gt; i < 262144 / 4; i += NGT) ((f32x4*)(p.out + O_RETP))[i] = (f32x4){0.f, 0.f, 0.f, 0.f};
}
constexpr int LDS_BYTES = 163840;
__global__ void __launch_bounds__(NTHR, 2) mk_fwd(KArgs ka) {
    extern __shared__ __attribute__((aligned(16))) unsigned char lds_raw[];
    LAS unsigned char* lds = (LAS unsigned char*)lds_raw;
    const Prm p = make_prm(ka);
    volatile LAS unsigned* bst = (volatile LAS unsigned*)(lds + LDS_BYTES - 16);
    int wave_s_ = __builtin_amdgcn_readfirstlane((int)threadIdx.x >> 6); asm volatile("" : "+s"(wave_s_)); const int wave_s = wave_s_;
    if (wave_s == 0 && lane_id() < 4) bst[lane_id()] = 0u;
    __syncthreads();
    const XcdBarrier xbar = xcd_barrier_post(p.CTL, bst, wave_s == 0);
#define GRID_SYNC() xcd_barrier(xbar)
#define PHASE_IDS() int wave = wave_s; asm volatile("" : "+s"(wave)); int tid = wave * 64 + lane_id(); asm volatile("" : "+v"(tid)); const int lane = tid & 63; (void)lane
#ifndef SKIP0
    { PHASE_IDS(); phase0<247>(p, lds, tid, lane, wave); }
#ifdef REP0
    GRID_SYNC(); { PHASE_IDS(); phase0<REP0>(p, lds, tid, lane, wave); }
#endif
#endif
    GRID_SYNC();
#ifndef SKIP1
    { asm volatile("" ::: "memory"); pg8::Gemm g{p.XN, p.WinT, MT, INWP, DM}; pg8::StaticOrder S; S.init(MT, INWP, (int)gridDim.x, (int)blockIdx.x); S.wv = wave_s; EpiZ E{p};
      pg8::gemm_phase<EpiZ, pg8::StaticOrder, true, true>(lds, g, S, E); }
#ifdef REP1
    GRID_SYNC();
    { asm volatile("" ::: "memory"); pg8::Gemm g{p.XN, p.WinT, MT, INWP, DM}; pg8::StaticOrder S; S.init(MT, INWP, (int)gridDim.x, (int)blockIdx.x); S.wv = wave_s; EpiZ E{p};
      pg8::gemm_phase<EpiZ, pg8::StaticOrder, true, true>(lds, g, S, E); }
#endif
#endif
    GRID_SYNC();
#ifndef SKIP2
    { PHASE_IDS(); phase2(p, lds, tid, lane, wave); }
#ifdef REP2
    GRID_SYNC(); { PHASE_IDS(); phase2<REP2>(p, lds, tid, lane, wave); }
#endif
#endif
    if (MK_LAST_PHASE <= 2) { dbg_fill(p, MK_LAST_PHASE, xbar, wave_s * 64 + lane_id()); return; }
    GRID_SYNC();
#ifndef SKIP3
    { PHASE_IDS(); phase3(p, lds, tid, lane, wave); }
#ifdef REP3
    GRID_SYNC(); { PHASE_IDS(); phase3<REP3>(p, lds, tid, lane, wave); }
#endif
#endif
    if (MK_LAST_PHASE <= 3) { dbg_fill(p, MK_LAST_PHASE, xbar, wave_s * 64 + lane_id()); return; }
    GRID_SYNC();
#ifndef SKIP4
    { PHASE_IDS(); phase4(p, lds, tid, lane, wave); }
#endif
    if (MK_LAST_PHASE <= 4) { dbg_fill(p, MK_LAST_PHASE, xbar, wave_s * 64 + lane_id()); return; }
    GRID_SYNC();
    { PHASE_IDS(); phase5a(p, lds, tid, lane, wave); }
    GRID_SYNC();
    { PHASE_IDS(); phase5b(p, lds, tid, lane, wave); }
    GRID_SYNC();
    { PHASE_IDS(); phase6c(p, lds, tid, lane, wave); }
    GRID_SYNC();
#ifdef REP7
    { PHASE_IDS(); phase7<REP7>(p, lds, tid, lane, wave); } GRID_SYNC();
#endif
    { PHASE_IDS(); phase7(p, lds, tid, lane, wave); }
    GRID_SYNC();
    { PHASE_IDS(); phase8a(p, lds, tid, lane, wave); }
    GRID_SYNC();
    { PHASE_IDS(); phase8b(p, lds, tid, lane, wave); }
    GRID_SYNC();
    { PHASE_IDS(); phase9s(p, lds, tid, lane, wave); }
}

extern "C" void kernel_launch(void* const* d_in, const int* in_sizes, int n_in, void* d_out, int out_size, void* d_ws, size_t ws_size, hipStream_t stream) {
    static int grid = 0;
    if (grid == 0) {
        int dev = 0, cus = 0, per_cu = 0;
        hipGetDevice(&dev);
        hipDeviceGetAttribute(&cus, hipDeviceAttributeMultiprocessorCount, dev);
        if (hipFuncSetAttribute((const void*)mk_fwd, hipFuncAttributeMaxDynamicSharedMemorySize, LDS_BYTES) != hipSuccess) { fprintf(stderr, "kernel_launch: hipFuncSetAttribute failed\n"); grid = -1; return; }
        if (hipOccupancyMaxActiveBlocksPerMultiprocessor(&per_cu, (const void*)mk_fwd, NTHR, LDS_BYTES) != hipSuccess || per_cu < 1) { fprintf(stderr, "kernel_launch: occupancy query says %d blocks per CU\n", per_cu); (void)hipGetLastError(); grid = -1; return; }
        grid = cus;
        if (n_in != 26 || out_size != (int)O_TOTAL) { fprintf(stderr, "kernel_launch: unexpected n_in %d / out_size %d\n", n_in, out_size); grid = -1; return; }
    }
    if (grid < 0) return;
    KArgs p{};
    for (int i = 0; i < 26; ++i) p.in[i] = (const float*)d_in[i];
    p.out = (float*)d_out; p.ws = (unsigned char*)d_ws;
    if (WSO.total > ws_size) { fprintf(stderr, "kernel_launch: workspace too small: need %zu, have %zu\n", (size_t)WSO.total, ws_size); return; }
    if (hipMemsetAsync((unsigned char*)d_ws + WSO.CTL, 0, 16384, stream) != hipSuccess) { fprintf(stderr, "kernel_launch: hipMemsetAsync failed\n"); return; }
    hipLaunchKernelGGL(mk_fwd, dim3(grid), dim3(NTHR), LDS_BYTES, stream, p);
    const hipError_t e = hipPeekAtLastError();
    if (e != hipSuccess) fprintf(stderr, "kernel_launch: launch failed: %s (grid %d)\n", hipGetErrorName(e), grid);
}
```
